# Optimizing an MI355X kernel written in HIP

```python
import math
import jax, jax.numpy as jnp
from jax import lax
import numpy as np

D_MODEL = 1024
BATCH = 8
SEQ = 4096
DEPTH = 2
DEC_BATCH = 4
DEC_SEQ = 8192
PAST_LEN = 128

MIX_WIDTH = D_MODEL
ATTN_WIDTH = MIX_WIDTH // 2
HG_WIDTH = MIX_WIDTH - ATTN_WIDTH
ATTN_HEAD_DIM = 64
ATTN_HEADS = ATTN_WIDTH // (2 * ATTN_HEAD_DIM)
ROT_DIM = ATTN_HEAD_DIM // 4
ROPE_THETA = 500000.0
Q_BLOCK = 128
HG_HEAD_DIM = 128
HG_HEADS = HG_WIDTH // HG_HEAD_DIM
HG_CHUNK = 64
D_FF = ((8 * D_MODEL // 3 + 127) // 128) * 128
ALPHA = (2 * DEPTH) ** 0.25
BETA = (8 * DEPTH) ** -0.25
EPS = 1e-5
IN_WIDTH = 3 * ATTN_WIDTH + 5 * HG_WIDTH
SPLITS = [ATTN_WIDTH, 2 * ATTN_WIDTH, 3 * ATTN_WIDTH,
          3 * ATTN_WIDTH + HG_WIDTH, 3 * ATTN_WIDTH + 2 * HG_WIDTH,
          3 * ATTN_WIDTH + 3 * HG_WIDTH, 3 * ATTN_WIDTH + 4 * HG_WIDTH]

kernel_name = "hymba_diffattn_hgrn2_macaron_deepnorm_encoder"


def layer_norm(x, g, b):
    xf = x.astype(jnp.float32)
    mu = jnp.mean(xf, axis=-1, keepdims=True)
    var = jnp.mean(jnp.square(xf - mu), axis=-1, keepdims=True)
    y = (xf - mu) * lax.rsqrt(var + EPS) * g.astype(jnp.float32) + b.astype(jnp.float32)
    return y.astype(x.dtype)


def rms_norm(x, g):
    xf = x.astype(jnp.float32)
    y = xf * lax.rsqrt(jnp.mean(jnp.square(xf), axis=-1, keepdims=True) + EPS) * g.astype(jnp.float32)
    return y.astype(x.dtype)


def swiglu(x, w_gate, w_up, w_down):
    hg = jnp.einsum('bsd,df->bsf', x, w_gate)
    hu = jnp.einsum('bsd,df->bsf', x, w_up)
    return jnp.einsum('bsf,fd->bsd', jax.nn.silu(hg) * hu, w_down)


def apply_partial_rope(x, pos):
    half = ROT_DIM // 2
    inv_freq = jnp.float32(ROPE_THETA) ** (-jnp.arange(half, dtype=jnp.float32) * 2.0 / ROT_DIM)
    ang = pos[:, None] * inv_freq[None, :]
    cos = jnp.cos(ang)[None, :, None, None, :]
    sin = jnp.sin(ang)[None, :, None, None, :]
    xr = x[..., :ROT_DIM].astype(jnp.float32)
    x1, x2 = xr[..., :half], xr[..., half:]
    rot = jnp.concatenate([x1 * cos - x2 * sin, x2 * cos + x1 * sin], axis=-1).astype(x.dtype)
    return jnp.concatenate([rot, x[..., ROT_DIM:]], axis=-1)


def diff_attention(q, k, v, lam):
    B, S, H, _, Dh = q.shape
    nq = S // Q_BLOCK
    scale = 1.0 / math.sqrt(Dh)
    qb = q.reshape(B, nq, Q_BLOCK, H, 2, Dh).transpose(1, 0, 2, 3, 4, 5)

    def one_block(qblk):
        s = jnp.einsum('bqhcd,bkhcd->bhcqk', qblk, k).astype(jnp.float32) * scale
        p = jax.nn.softmax(s, axis=-1)
        p = p[:, :, 0] - lam * p[:, :, 1]
        return jnp.einsum('bhqk,bkhe->bqhe', p.astype(v.dtype), v)

    o = lax.map(one_block, qb)
    return o.transpose(1, 0, 2, 3, 4).reshape(B, S, H, v.shape[-1])


def hgrn2_chunk_scan(q, k, v, log_f):
    B, S, H, Dk = q.shape
    Dv = v.shape[-1]
    n = S // HG_CHUNK

    def to_chunks(x):
        return x.reshape(B, n, HG_CHUNK, H, x.shape[-1]).transpose(1, 0, 3, 2, 4)

    mask = jnp.tril(jnp.ones((HG_CHUNK, HG_CHUNK), dtype=bool))

    def step(state, inp):
        qc, kc, vc, gc = inp
        b = jnp.cumsum(gc, axis=2)
        rel = jnp.where(mask[:, :, None], b[:, :, :, None, :] - b[:, :, None, :, :], -jnp.inf)
        scores = jnp.einsum('bhtk,bhsk,bhtsk->bhts', qc, kc, jnp.exp(rel))
        o = (jnp.einsum('bhts,bhsv->bhtv', scores, vc)
             + jnp.einsum('bhtk,bhkv->bhtv', qc * jnp.exp(b), state))
        b_last = b[:, :, -1:, :]
        state = (state * jnp.exp(b_last)[:, :, 0, :, None]
                 + jnp.einsum('bhsk,bhsv->bhkv', kc * jnp.exp(b_last - b), vc))
        return state, o

    init = jnp.zeros((B, H, Dk, Dv), jnp.float32)
    _, o = lax.scan(step, init, (to_chunks(q), to_chunks(k), to_chunks(v), to_chunks(log_f)))
    return o.transpose(1, 0, 3, 2, 4).reshape(B, S, H, Dv)


def hgrn2_direction(q, f_logit, lb, v, reverse):
    B, S = f_logit.shape[:2]
    z = f_logit.astype(jnp.float32).reshape(B, S, HG_HEADS, HG_HEAD_DIM)
    lbh = lb.reshape(HG_HEADS, HG_HEAD_DIM)
    log_f = jnp.logaddexp(jnp.log(lbh), jnp.log1p(-lbh) + jax.nn.log_sigmoid(z))
    k = -jnp.expm1(log_f)
    if reverse:
        q, k, v, log_f = (jnp.flip(t, axis=1) for t in (q, k, v, log_f))
    o = hgrn2_chunk_scan(q, k, v, log_f)
    if reverse:
        o = jnp.flip(o, axis=1)
    return o


def token_mixer(h, w_in, w_out, lam_p, lam_init, attn_g, hg_g, lb_fwd, lb_bwd):
    B, S, _ = h.shape
    proj = jnp.einsum('bsd,de->bse', h, w_in)
    aq, ak, av, hq, hf_fwd, hf_bwd, hi, hgate = jnp.split(proj, SPLITS, axis=-1)

    pos = jnp.arange(S, dtype=jnp.float32)
    aq = apply_partial_rope(aq.reshape(B, S, ATTN_HEADS, 2, ATTN_HEAD_DIM), pos)
    ak = apply_partial_rope(ak.reshape(B, S, ATTN_HEADS, 2, ATTN_HEAD_DIM), pos)
    av = av.reshape(B, S, ATTN_HEADS, 2 * ATTN_HEAD_DIM)
    lp = lam_p.astype(jnp.float32)
    lam = jnp.exp(jnp.sum(lp[0] * lp[1])) - jnp.exp(jnp.sum(lp[2] * lp[3])) + lam_init
    ao = diff_attention(aq, ak, av, lam)
    ao = rms_norm(ao, attn_g) * (1.0 - lam_init)

    qf = jax.nn.silu(hq.astype(jnp.float32)).reshape(B, S, HG_HEADS, HG_HEAD_DIM)
    vf = hi.astype(jnp.float32).reshape(B, S, HG_HEADS, HG_HEAD_DIM)
    ho = (hgrn2_direction(qf, hf_fwd, lb_fwd, vf, False)
          + hgrn2_direction(qf, hf_bwd, lb_bwd, vf, True)).astype(h.dtype)
    ho = rms_norm(ho, hg_g) * jax.nn.silu(hgate).reshape(B, S, HG_HEADS, HG_HEAD_DIM)

    mixed = jnp.concatenate([ao.reshape(B, S, ATTN_WIDTH), ho.reshape(B, S, HG_WIDTH)], axis=-1)
    return jnp.einsum('bse,ed->bsd', mixed, w_out)


def trunk(x, w_in, w_out, attn_lambda, attn_norm_g, hg_norm_g, hg_lower_bound,
          ffn_w_gate, ffn_w_up, ffn_w_down, ln_g, ln_b):
    p = jax.nn.softmax(hg_lower_bound.astype(jnp.float32), axis=1)
    lbs = jnp.maximum(jnp.cumsum(p, axis=1) - p[:, :1], 0.0)
    for l in range(DEPTH):
        lam_init = 0.8 - 0.6 * math.exp(-0.3 * l)
        x = layer_norm(ALPHA * x + 0.5 * swiglu(x, ffn_w_gate[l, 0], ffn_w_up[l, 0], ffn_w_down[l, 0]),
                       ln_g[l, 0], ln_b[l, 0])
        x = layer_norm(ALPHA * x + token_mixer(x, w_in[l], w_out[l], attn_lambda[l], lam_init,
                                               attn_norm_g[l], hg_norm_g[l], lbs[0, l], lbs[1, l]),
                       ln_g[l, 1], ln_b[l, 1])
        x = layer_norm(ALPHA * x + 0.5 * swiglu(x, ffn_w_gate[l, 1], ffn_w_up[l, 1], ffn_w_down[l, 1]),
                       ln_g[l, 2], ln_b[l, 2])
    return x


def setup_inputs(seed: int = 0) -> dict:
    key = jax.random.key(seed)
    ks = jax.random.split(key, 14)
    f32 = jnp.float32
    x_prompt = jax.random.normal(ks[0], (BATCH, SEQ, D_MODEL), f32)
    x_sample = jax.random.normal(ks[1], (DEC_BATCH, DEC_SEQ, D_MODEL), f32)
    col_scale = jnp.concatenate([
        jnp.ones((2 * ATTN_WIDTH,), f32), jnp.full((ATTN_WIDTH,), BETA, f32),
        jnp.ones((3 * HG_WIDTH,), f32), jnp.full((HG_WIDTH,), BETA, f32),
        jnp.ones((HG_WIDTH,), f32)])
    w_in = jax.random.normal(ks[2], (DEPTH, D_MODEL, IN_WIDTH), f32) * (D_MODEL ** -0.5) * col_scale
    w_out = jax.random.normal(ks[3], (DEPTH, MIX_WIDTH, D_MODEL), f32) * (MIX_WIDTH ** -0.5) * BETA
    attn_lambda = jax.random.normal(ks[4], (DEPTH, 4, ATTN_HEAD_DIM), f32) * 0.1
    attn_norm_g = 1.0 + 0.02 * jax.random.normal(ks[5], (DEPTH, 2 * ATTN_HEAD_DIM), f32)
    hg_norm_g = 1.0 + 0.02 * jax.random.normal(ks[6], (DEPTH, HG_HEAD_DIM), f32)
    hg_lower_bound = jax.random.normal(ks[7], (2, DEPTH, HG_WIDTH), f32)
    ffn_w_gate = jax.random.normal(ks[8], (DEPTH, 2, D_MODEL, D_FF), f32) * (D_MODEL ** -0.5)
    ffn_w_up = jax.random.normal(ks[9], (DEPTH, 2, D_MODEL, D_FF), f32) * (D_MODEL ** -0.5)
    ffn_w_down = jax.random.normal(ks[10], (DEPTH, 2, D_FF, D_MODEL), f32) * (D_FF ** -0.5) * BETA
    ln_g = 1.0 + 0.02 * jax.random.normal(ks[11], (DEPTH, 3, D_MODEL), f32)
    ln_b = 0.02 * jax.random.normal(ks[12], (DEPTH, 3, D_MODEL), f32)
    return {"x_prompt": x_prompt, "x_sample": x_sample, "w_in": w_in, "w_out": w_out,
            "attn_lambda": attn_lambda, "attn_norm_g": attn_norm_g, "hg_norm_g": hg_norm_g,
            "hg_lower_bound": hg_lower_bound, "ffn_w_gate": ffn_w_gate, "ffn_w_up": ffn_w_up,
            "ffn_w_down": ffn_w_down, "ln_g": ln_g, "ln_b": ln_b}


def reference(x_prompt, x_sample, w_in, w_out, attn_lambda, attn_norm_g, hg_norm_g, hg_lower_bound,
              ffn_w_gate, ffn_w_up, ffn_w_down, ln_g, ln_b):
    y_prompt = trunk(x_prompt, w_in, w_out, attn_lambda, attn_norm_g, hg_norm_g, hg_lower_bound,
                     ffn_w_gate, ffn_w_up, ffn_w_down, ln_g, ln_b)
    y_sample = trunk(x_sample, w_in, w_out, attn_lambda, attn_norm_g, hg_norm_g, hg_lower_bound,
                     ffn_w_gate, ffn_w_up, ffn_w_down, ln_g, ln_b)
    return (y_prompt, y_sample)
```

```cpp
#include <hip/hip_runtime.h>
#include <hip/hip_cooperative_groups.h>
#include <cstdio>
#include <cstdint>
namespace cg = cooperative_groups;

#define LAS __attribute__((address_space(3)))
typedef unsigned short bf16_t;
typedef short bf16x8 __attribute__((ext_vector_type(8)));
typedef short s16x4 __attribute__((ext_vector_type(4)));
typedef float f32x4 __attribute__((ext_vector_type(4)));
typedef float f32x2 __attribute__((ext_vector_type(2)));
typedef float f32x16 __attribute__((ext_vector_type(16)));
typedef unsigned u32x4 __attribute__((ext_vector_type(4)));
typedef unsigned u32x2 __attribute__((ext_vector_type(2)));

constexpr int DM = 1024, MTOK = 65536, MP = 32768, DFF = 2816, NGU = 5632, NIN = 4096;
constexpr float ALPHA = 1.4142135623730951f, EPS = 1e-5f, LOG2E = 1.4426950408889634f;
constexpr float QSCALE = 0.125f * 1.4426950408889634f;
constexpr size_t MiB = 1u << 20;
constexpr size_t WS_CTL = 0;
constexpr size_t WS_STATS = 480 * MiB;
constexpr size_t WS_ROPE = 4 * MiB;
constexpr size_t WS_VEC = 5 * MiB;
constexpr size_t WS_WGU = 6 * MiB, WS_WD = 50 * MiB, WS_WIN = 72 * MiB, WS_WOUT = 88 * MiB;
constexpr size_t WS_Z = 96 * MiB, WS_BIGS = 224 * MiB, WS_END = 496 * MiB;
constexpr size_t STAT_STRIDE = (size_t)MTOK * 32;
constexpr int V_C1GU = 0, V_C2GU = 4 * NGU, V_C1IN = 8 * NGU, V_C2IN = 8 * NGU + 2 * NIN;

typedef __bf16 bf16x2_t __attribute__((ext_vector_type(2)));
__device__ __forceinline__ unsigned cvt_pk_bf16(float lo, float hi) { const f32x2 v = {lo, hi}; const bf16x2_t b = __builtin_convertvector(v, bf16x2_t); return __builtin_bit_cast(unsigned, b); }
typedef _Float16 h16x2_t __attribute__((ext_vector_type(2)));
__device__ __forceinline__ unsigned cvt_pk_f16(float lo, float hi) { const f32x2 v = {lo, hi}; const h16x2_t b = __builtin_convertvector(v, h16x2_t); return __builtin_bit_cast(unsigned, b); }
__device__ __forceinline__ float h_lo(unsigned u) { return (float)__builtin_bit_cast(h16x2_t, u)[0]; }
__device__ __forceinline__ float h_hi(unsigned u) { return (float)__builtin_bit_cast(h16x2_t, u)[1]; }
__device__ __forceinline__ float bf_lo(unsigned u) { return __uint_as_float(u << 16); }
__device__ __forceinline__ float bf_hi(unsigned u) { return __uint_as_float(u & 0xffff0000u); }
__device__ __forceinline__ float ex2(float x) { return __builtin_amdgcn_exp2f(x); }
__device__ __forceinline__ float silu_f(float x) { return x * __builtin_amdgcn_rcpf(1.f + ex2(-x * LOG2E)); }
__device__ __forceinline__ void row_stat(const float* st, int row, int fq, float& mu, float& rs) {
    if (!st) { mu = 0.f; rs = 1.f; return; }
    const float* p = st + (size_t)row * 32 + fq * 8;
    const f32x4 a = *(const f32x4*)p, b = *(const f32x4*)(p + 4);
    float s = (a.x + a.z) + (b.x + b.z), ss = (a.y + a.w) + (b.y + b.w);
    s += __shfl_xor(s, 16); s += __shfl_xor(s, 32); ss += __shfl_xor(ss, 16); ss += __shfl_xor(ss, 32);
    mu = s * (1.f / DM); const float var = ss * (1.f / DM) - mu * mu; rs = rsqrtf(fmaxf(var, 0.f) + EPS);
}

namespace pg8 {
constexpr int BM = 256, BK = 64, HALF = 128, HTB = HALF * BK * 2, STAGE_BYTES = 8 * HTB, NXCD = 8, WGM = 8;
__host__ __device__ __forceinline__ int lds_byte(int r, int c) { const int st = (r >> 4) * 2 + (c >> 5), rr = r & 15, cc = c & 31, ob = rr * 64 + cc * 2; return st * 1024 + (ob ^ (((ob >> 9) & 1) << 5)); }
__host__ __device__ __forceinline__ void stage_rc(int b, int& R, int& C) { const int st = b / 1024, sb = b % 1024, swz = sb ^ (((sb >> 9) & 1) << 5); R = (st >> 1) * 16 + swz / 64; C = (st & 1) * 32 + (swz % 64) / 2; }
__host__ __device__ __forceinline__ int perm32(int rho) { const int n = rho >> 4, i = rho & 15; return 8 * (i >> 2) + 4 * n + (i & 3); }
struct Unit { int pm, pn; };
struct Gemm { const bf16_t* A0; const bf16_t* A1; int lda; const bf16_t* Bt; int M, N, K; };
struct StaticOrder {
    int nM, nN, nwg, G, c;
    __host__ __device__ void init(int M, int N, int G_, int c_) { nM = M / BM; nN = N / BM; nwg = nM * nN; G = G_; c = c_; }
    __host__ __device__ bool next(int i, Unit& u) const {
        const long L = (long)i * G + c; if (L >= nwg) return false;
        int wgid = (int)L; { const int q = nwg / NXCD, r = nwg % NXCD, xcd = wgid % NXCD, off = wgid / NXCD; wgid = (xcd < r ? xcd * (q + 1) : r * (q + 1) + (xcd - r) * q) + off; }
        const int nig = WGM * nN, gid = wgid / nig, fm = gid * WGM, gsz = (nM - fm) < WGM ? (nM - fm) : WGM;
        u.pm = fm + ((wgid % nig) % gsz); u.pn = (wgid % nig) / gsz; return true;
    }
};

struct EpiSwiGLU {
    static constexpr bool PERM = true;
    bf16_t* H0; bf16_t* H1; const float* st; const float* c1; const float* c2;
    __device__ __forceinline__ const float* stat_ptr() const { return st; }
    __device__ __forceinline__ const float* v1_ptr() const { return c1; }
    __device__ __forceinline__ const float* v2_ptr() const { return c2; }
    __device__ __forceinline__ void operator()(const f32x4 (&acc)[2][2][4][2], const Unit& u, int wr, int wc, int fr, int fq, const LAS f32x2* S, const LAS float* C) const {
        const int colw = wc * 32 + 8 * fq, cb = u.pn * 256 + colw;
#pragma unroll
        for (int ai = 0; ai < 2; ++ai)
#pragma unroll
            for (int m = 0; m < 4; ++m) {
                const int row = u.pm * 256 + ai * 128 + wr * 64 + m * 16 + fr; const f32x2 sr_ = S[ai * 128 + wr * 64 + m * 16 + fr]; const float mu = sr_.x, rs = sr_.y;
                bf16_t* rowp = (row < MP ? H0 + (size_t)row * DFF : H1 + (size_t)(row - MP) * DFF) + u.pn * 128 + colw;
                unsigned wv[4];
#pragma unroll
                for (int n = 0; n < 2; ++n) {
                    const f32x4 c1g = *(const LAS f32x4*)(C + colw + 4 * n), c1u = *(const LAS f32x4*)(C + colw + 128 + 4 * n), c2g = *(const LAS f32x4*)(C + 256 + colw + 4 * n), c2u = *(const LAS f32x4*)(C + 256 + colw + 128 + 4 * n);
                    float hv[4];
#pragma unroll
                    for (int j = 0; j < 4; ++j) {
                        const float vg = (acc[ai][0][m][n][j] - mu * c1g[j]) * rs + c2g[j];
                        const float vu = (acc[ai][1][m][n][j] - mu * c1u[j]) * rs + c2u[j];
                        hv[j] = silu_f(vg) * vu; }
                    wv[2 * n] = cvt_pk_bf16(hv[0], hv[1]); wv[2 * n + 1] = cvt_pk_bf16(hv[2], hv[3]);
                }
                *(u32x4*)rowp = (u32x4){wv[0], wv[1], wv[2], wv[3]};
                asm volatile("" ::: "memory");
            }
    }
};
struct EpiResid {
    static constexpr bool PERM = true;
    bf16_t* Z; const float* st_in; const float* lng; const float* lnb; float* st_out; float bscale;
    __device__ __forceinline__ const float* stat_ptr() const { return st_in; }
    __device__ __forceinline__ const float* v1_ptr() const { return lng; }
    __device__ __forceinline__ const float* v2_ptr() const { return lnb; }
    __device__ __forceinline__ void operator()(const f32x4 (&acc)[2][2][4][2], const Unit& u, int wr, int wc, int fr, int fq, const LAS f32x2* S, const LAS float* C) const {
        const int col0 = u.pn * 256 + wc * 32 + 8 * fq;
#pragma unroll
        for (int ai = 0; ai < 2; ++ai) {
            u32x4 zin[4][2];
#pragma unroll
            for (int m = 0; m < 4; ++m)
#pragma unroll
                for (int bj = 0; bj < 2; ++bj) zin[m][bj] = *(const u32x4*)(Z + (size_t)(u.pm * 256 + ai * 128 + wr * 64 + m * 16 + fr) * DM + col0 + bj * 128);
#pragma unroll
            for (int m = 0; m < 4; ++m) {
                const int row = u.pm * 256 + ai * 128 + wr * 64 + m * 16 + fr; const f32x2 sr_ = S[ai * 128 + wr * 64 + m * 16 + fr]; const float mu = sr_.x, rs = sr_.y;
                float s = 0.f, ss = 0.f;
#pragma unroll
                for (int bj = 0; bj < 2; ++bj) {
                    bf16_t* p = Z + (size_t)row * DM + col0 + bj * 128;
                    const u32x4 zo = zin[m][bj]; float zf[8];
                    zf[0] = bf_lo(zo.x); zf[1] = bf_hi(zo.x); zf[2] = bf_lo(zo.y); zf[3] = bf_hi(zo.y); zf[4] = bf_lo(zo.z); zf[5] = bf_hi(zo.z); zf[6] = bf_lo(zo.w); zf[7] = bf_hi(zo.w);
                    float zn[8];
#pragma unroll
                    for (int n = 0; n < 2; ++n) {
                        f32x4 gv = {1.f, 1.f, 1.f, 1.f}, bv = {0.f, 0.f, 0.f, 0.f};
                        if (st_in) { gv = *(const LAS f32x4*)(C + wc * 32 + 8 * fq + bj * 128 + 4 * n); bv = *(const LAS f32x4*)(C + 256 + wc * 32 + 8 * fq + bj * 128 + 4 * n); }
#pragma unroll
                        for (int j = 0; j < 4; ++j) { const float xn = (zf[4 * n + j] - mu) * rs * gv[j] + bv[j]; zn[4 * n + j] = ALPHA * xn + bscale * acc[ai][bj][m][n][j]; } }
                    u32x4 w; w.x = cvt_pk_bf16(zn[0], zn[1]); w.y = cvt_pk_bf16(zn[2], zn[3]); w.z = cvt_pk_bf16(zn[4], zn[5]); w.w = cvt_pk_bf16(zn[6], zn[7]);
                    *(u32x4*)p = w;
                    const float r0 = bf_lo(w.x), r1 = bf_hi(w.x), r2 = bf_lo(w.y), r3 = bf_hi(w.y), r4 = bf_lo(w.z), r5 = bf_hi(w.z), r6 = bf_lo(w.w), r7 = bf_hi(w.w);
                    s += ((r0 + r1) + (r2 + r3)) + ((r4 + r5) + (r6 + r7));
                    ss += ((r0 * r0 + r1 * r1) + (r2 * r2 + r3 * r3)) + ((r4 * r4 + r5 * r5) + (r6 * r6 + r7 * r7));
                }
                s += __shfl_xor(s, 16); s += __shfl_xor(s, 32); ss += __shfl_xor(ss, 16); ss += __shfl_xor(ss, 32);
                if (fq == 0) *(f32x2*)(st_out + (size_t)row * 32 + (u.pn * 4 + wc) * 2) = (f32x2){s, ss};
                asm volatile("" ::: "memory");
            }
        }
    }
};
struct EpiProj {
    static constexpr bool PERM = true;
    bf16_t* P0; bf16_t* P1; const float* st; const float* c1; const float* c2; const float* rope; const float* lbf; const float* lbb;
    __device__ __forceinline__ const float* stat_ptr() const { return st; }
    __device__ __forceinline__ const float* v1_ptr() const { return nullptr; }
    __device__ __forceinline__ const float* v2_ptr() const { return nullptr; }
    __device__ __forceinline__ void operator()(const f32x4 (&acc)[2][2][4][2], const Unit& u, int wr, int wc, int fr, int fq, const LAS f32x2* S, const LAS float* C) const {
        const int grp = u.pn >> 1, colt = u.pn * 256 + wc * 32 + 8 * fq, cgrp = (u.pn & 1) * 256 + wc * 32 + 8 * fq;
        const bool isf = (grp == 4 || grp == 5); const float* lbp = (grp == 4) ? lbf : lbb;
        const bool ropew = (grp == 0 || grp == 2) && !(wc & 1);
#pragma unroll
        for (int bj = 0; bj < 2; ++bj) {
            const f32x4 c1a = *(const f32x4*)(c1 + colt + bj * 128), c1b = *(const f32x4*)(c1 + colt + bj * 128 + 4), c2a = *(const f32x4*)(c2 + colt + bj * 128), c2b = *(const f32x4*)(c2 + colt + bj * 128 + 4);
            f32x4 lb0 = {0.f, 0.f, 0.f, 0.f}, lb1 = {0.f, 0.f, 0.f, 0.f};
            if (isf) { lb0 = *(const f32x4*)(lbp + cgrp + bj * 128); lb1 = *(const f32x4*)(lbp + cgrp + bj * 128 + 4); }
            f32x4 ncs0 = {0.f, 0.f, 0.f, 0.f}, ncs1 = ncs0, nsn0 = ncs0, nsn1 = ncs0;
            if (ropew) { const int row0_ = u.pm * 256 + wr * 64 + fr; const int pos0_ = row0_ < MP ? (row0_ & 4095) : (row0_ & 8191); const float* rp_ = rope + (size_t)pos0_ * 16;
                ncs0 = *(const f32x4*)rp_; ncs1 = *(const f32x4*)(rp_ + 4); nsn0 = *(const f32x4*)(rp_ + 8); nsn1 = *(const f32x4*)(rp_ + 12); }
#pragma unroll
            for (int ai = 0; ai < 2; ++ai)
#pragma unroll
                for (int m = 0; m < 4; ++m) {
                    const int row = u.pm * 256 + ai * 128 + wr * 64 + m * 16 + fr; const f32x2 sr_ = S[ai * 128 + wr * 64 + m * 16 + fr]; const float mu = sr_.x, rs = sr_.y;
                    const f32x4 cs0 = ncs0, cs1 = ncs1, sn0 = nsn0, sn1 = nsn1;
                    if (ropew && (ai * 4 + m) < 7) { const int im_ = ai * 4 + m + 1; const int rown_ = u.pm * 256 + (im_ >> 2) * 128 + wr * 64 + (im_ & 3) * 16 + fr; const int posn_ = rown_ < MP ? (rown_ & 4095) : (rown_ & 8191);
                        const float* rp_ = rope + (size_t)posn_ * 16; ncs0 = *(const f32x4*)rp_; ncs1 = *(const f32x4*)(rp_ + 4); nsn0 = *(const f32x4*)(rp_ + 8); nsn1 = *(const f32x4*)(rp_ + 12); }
                    bf16_t* rowp = (row < MP ? P0 + (size_t)row * NIN : P1 + (size_t)(row - MP) * NIN) + colt + bj * 128;
                    f32x4 v0 = (acc[ai][bj][m][0] - mu * c1a) * rs + c2a;
                    f32x4 v1 = (acc[ai][bj][m][1] - mu * c1b) * rs + c2b;
                    if (ropew) {
                        f32x4 p0, p1;
#pragma unroll
                        for (int j = 0; j < 4; ++j) { p0[j] = __shfl_xor(v0[j], 16); p1[j] = __shfl_xor(v1[j], 16); }
                        if (fq == 0) { v0 = v0 * cs0 - p0 * sn0; v1 = v1 * cs1 - p1 * sn1; }
                        else if (fq == 1) { v0 = v0 * cs0 + p0 * sn0; v1 = v1 * cs1 + p1 * sn1; }
                    }
                    if (grp == 0) { v0 = v0 * QSCALE; v1 = v1 * QSCALE; }
                    else if (grp == 1 || grp == 7) {
#pragma unroll
                        for (int j = 0; j < 4; ++j) { v0[j] = silu_f(v0[j]); v1[j] = silu_f(v1[j]); } }
                    else if (isf) {
#pragma unroll
                        for (int j = 0; j < 4; ++j) {
                            const float s0 = __builtin_amdgcn_rcpf(1.f + ex2(-v0[j] * LOG2E)), s1 = __builtin_amdgcn_rcpf(1.f + ex2(-v1[j] * LOG2E));
                            v0[j] = __builtin_amdgcn_logf(lb0[j] + (1.f - lb0[j]) * s0); v1[j] = __builtin_amdgcn_logf(lb1[j] + (1.f - lb1[j]) * s1); } }
                    u32x4 w;
                    if (grp == 1 || grp == 7 || isf) { w.x = cvt_pk_f16(v0[0], v0[1]); w.y = cvt_pk_f16(v0[2], v0[3]); w.z = cvt_pk_f16(v1[0], v1[1]); w.w = cvt_pk_f16(v1[2], v1[3]); }
                    else { w.x = cvt_pk_bf16(v0[0], v0[1]); w.y = cvt_pk_bf16(v0[2], v0[3]); w.z = cvt_pk_bf16(v1[0], v1[1]); w.w = cvt_pk_bf16(v1[2], v1[3]); }
                    *(u32x4*)rowp = w;
                    asm volatile("" ::: "memory");
                }
        }
    }
};

template <class Epi>
__device__ __forceinline__ void gemm_phase(LAS unsigned char* lds, const Gemm g, const StaticOrder& S, const Epi& E) {
    int tid = threadIdx.x; asm volatile("" : "+v"(tid));
    const int wid = __builtin_amdgcn_readfirstlane(tid >> 6), lane = tid & 63, wr = wid >> 2, wc = wid & 3, fr = lane & 15, fq = lane >> 4;
    const int K = g.K, nt = K / BK, lda = g.lda;
    unsigned voffA[2], voffB[2];
#pragma unroll
    for (int i = 0; i < 2; ++i) { int R, C; stage_rc(tid * 16 + i * 8192, R, C); const int Rb = Epi::PERM ? ((R & ~31) + perm32(R & 31)) : R;
        voffA[i] = (unsigned)(R * lda + C) * 2u; voffB[i] = (unsigned)(Rb * K + C) * 2u; }
    const size_t kstep = (size_t)(BK * 2);
    const size_t hstepA = (size_t)HALF * lda * 2, hstepB = (size_t)HALF * K * 2, tstepA = 2 * hstepA, tstepB = 2 * hstepB;
    const unsigned ldsw = (unsigned)wid * 1024u;
    const int aoff = lds_byte(wr * 64 + fr, fq * 8), boff = lds_byte(wc * 32 + fr, fq * 8);
#define PG8_ABASE(pm) ((pm) < 128 ? (const char*)g.A0 + (size_t)(pm) * tstepA : (const char*)g.A1 + (size_t)((pm) - 128) * tstepA)
#define PG8_SA(b, h) (((b) * 2 + (h)) * HTB)
#define PG8_SB(b, h) ((4 + (b) * 2 + (h)) * HTB)
#define PG8_STAGE(bufoff, gbase, voff) do { _Pragma("unroll") for (int _i = 0; _i < 2; ++_i) \
        __builtin_amdgcn_global_load_lds((const unsigned*)((const char*)(gbase) + (voff)[_i]), (LAS unsigned*)(lds + (bufoff) + ldsw + _i * 8192), 16, 0, 0); } while (0)
#define PG8_LDA(dst, b, h) do { _Pragma("unroll") for (int m = 0; m < 4; ++m) _Pragma("unroll") for (int k = 0; k < 2; ++k) dst[m][k] = *(const LAS bf16x8*)(lds + PG8_SA(b, h) + aoff + m * 2048 + k * 1024); } while (0)
#define PG8_LDB(dst, b, h) do { _Pragma("unroll") for (int n = 0; n < 2; ++n) _Pragma("unroll") for (int k = 0; k < 2; ++k) dst[n][k] = *(const LAS bf16x8*)(lds + PG8_SB(b, h) + boff + n * 2048 + k * 1024); } while (0)
#define PG8_MMA(ai, bj, At, Bt) do { __builtin_amdgcn_s_setprio(1); _Pragma("unroll") for (int m = 0; m < 4; ++m) _Pragma("unroll") for (int n = 0; n < 2; ++n) _Pragma("unroll") for (int k = 0; k < 2; ++k) \
        acc[ai][bj][m][n] = __builtin_amdgcn_mfma_f32_16x16x32_bf16(Bt[n][k], At[m][k], acc[ai][bj][m][n], 0, 0, 0); __builtin_amdgcn_s_setprio(0); } while (0)
#define PG8_WAIT_V(n) asm volatile("s_waitcnt vmcnt(" #n ")" ::: "memory")
#define PG8_WAIT_L(n) asm volatile("s_waitcnt lgkmcnt(" #n ")" ::: "memory")
#define PG8_BAR __builtin_amdgcn_s_barrier()
#define PG8_SCHED __builtin_amdgcn_sched_barrier(0)
    Unit cur, nxt; int ui = 0;
    if (!S.next(0, cur)) return;
    f32x4 acc[2][2][4][2];
#pragma unroll
    for (int a = 0; a < 2; ++a)
#pragma unroll
        for (int b = 0; b < 2; ++b)
#pragma unroll
            for (int m = 0; m < 4; ++m)
#pragma unroll
                for (int n = 0; n < 2; ++n) acc[a][b][m][n] = (f32x4){0.f, 0.f, 0.f, 0.f};
    bf16x8 At[4][2], B0[2][2], B1[2][2];
    const char* cA = PG8_ABASE(cur.pm); const char* cB = (const char*)g.Bt + (size_t)cur.pn * tstepB;
    PG8_STAGE(PG8_SB(0, 0), cB, voffB); PG8_STAGE(PG8_SB(0, 1), cB + hstepB, voffB); PG8_STAGE(PG8_SA(0, 0), cA, voffA); PG8_STAGE(PG8_SA(0, 1), cA + hstepA, voffA);
    if (wr == 1) PG8_BAR;
    PG8_WAIT_V(2); PG8_BAR;
    PG8_STAGE(PG8_SB(1, 0), cB + kstep, voffB); PG8_STAGE(PG8_SA(1, 0), cA + kstep, voffA); PG8_STAGE(PG8_SB(1, 1), cB + hstepB + kstep, voffB);
    PG8_WAIT_V(6); PG8_BAR;
    for (;;) {
        const bool has_next = S.next(ui + 1, nxt);
        { LAS f32x2* Sw = (LAS f32x2*)(lds + 131072 + 1024 + (ui & 1) * 2048); const float* stp = E.stat_ptr(); float mu_ = 0.f, rs_ = 1.f;
          if (stp) { const float* p_ = stp + (size_t)(cur.pm * 256 + (tid >> 1)) * 32 + (tid & 1) * 16;
              const f32x4 a_ = *(const f32x4*)p_, b_ = *(const f32x4*)(p_ + 4), c_ = *(const f32x4*)(p_ + 8), d_ = *(const f32x4*)(p_ + 12);
              float s_ = ((a_.x + a_.z) + (b_.x + b_.z)) + ((c_.x + c_.z) + (d_.x + d_.z)), q_ = ((a_.y + a_.w) + (b_.y + b_.w)) + ((c_.y + c_.w) + (d_.y + d_.w));
              s_ += __shfl_xor(s_, 1); q_ += __shfl_xor(q_, 1);
              mu_ = s_ * (1.f / DM); rs_ = rsqrtf(fmaxf(q_ * (1.f / DM) - mu_ * mu_, 0.f) + EPS); }
          if ((tid & 1) == 0) Sw[tid >> 1] = (f32x2){mu_, rs_};
          if (tid < 128) { const float* vp_ = (tid < 64) ? E.v1_ptr() : E.v2_ptr(); LAS float* Cw = (LAS float*)(lds + 131072 + 1024 + 4096 + (ui & 1) * 2048);
              const f32x4 v_ = vp_ ? *(const f32x4*)(vp_ + cur.pn * 256 + 4 * (tid & 63)) : (f32x4){0.f, 0.f, 0.f, 0.f};
              *(LAS f32x4*)(Cw + (tid >> 6) * 256 + 4 * (tid & 63)) = v_; } }
        const char* nA = has_next ? PG8_ABASE(nxt.pm) : cA; const char* nB = has_next ? (const char*)g.Bt + (size_t)nxt.pn * tstepB : cB;
        for (int t = 0; t < nt; t += 2) {
            const bool last = (t == nt - 2);
            const char* a1 = cA + (size_t)(t + 1) * kstep;
            const char* a2 = last ? nA : cA + (size_t)(t + 2) * kstep; const char* b2 = last ? nB : cB + (size_t)(t + 2) * kstep;
            const char* a3 = a2 + kstep; const char* b3 = b2 + kstep;
            PG8_LDB(B0, 0, 0); PG8_LDB(B1, 0, 1); PG8_SCHED; PG8_LDA(At, 0, 0); PG8_STAGE(PG8_SA(1, 1), a1 + hstepA, voffA);
            PG8_WAIT_V(8); PG8_WAIT_L(0); PG8_BAR; PG8_MMA(0, 0, At, B0); PG8_MMA(0, 1, At, B1); PG8_BAR; PG8_SCHED;
            PG8_LDA(At, 0, 1); PG8_STAGE(PG8_SB(0, 0), b2, voffB); PG8_STAGE(PG8_SB(0, 1), b2 + hstepB, voffB); PG8_STAGE(PG8_SA(0, 0), a2, voffA);
            PG8_WAIT_V(8); PG8_WAIT_L(0); PG8_BAR; PG8_MMA(1, 0, At, B0); PG8_MMA(1, 1, At, B1); PG8_BAR; PG8_SCHED;
            PG8_LDB(B0, 1, 0); PG8_LDB(B1, 1, 1); PG8_SCHED; PG8_LDA(At, 1, 0); PG8_STAGE(PG8_SA(0, 1), a2 + hstepA, voffA);
            PG8_WAIT_V(8); PG8_WAIT_L(0); PG8_BAR; PG8_MMA(0, 0, At, B0); PG8_MMA(0, 1, At, B1); PG8_BAR; PG8_SCHED;
            PG8_LDA(At, 1, 1); PG8_STAGE(PG8_SB(1, 0), b3, voffB); PG8_STAGE(PG8_SB(1, 1), b3 + hstepB, voffB); PG8_STAGE(PG8_SA(1, 0), a3, voffA);
            PG8_WAIT_V(8); PG8_WAIT_L(0); PG8_BAR; PG8_MMA(1, 0, At, B0); PG8_MMA(1, 1, At, B1); PG8_BAR; PG8_SCHED;
        }
        if (wr == 0) PG8_BAR;
#ifndef SKIP_EPI
        E(acc, cur, wr, wc, fr, fq, (const LAS f32x2*)(lds + 131072 + 1024 + (ui & 1) * 2048), (const LAS float*)(lds + 131072 + 1024 + 4096 + (ui & 1) * 2048));
#else
        if (acc[0][0][0][0][0] + acc[1][1][3][1][3] + acc[0][1][2][0][1] + acc[1][0][1][1][2] == 12345.f) ((float*)g.A0)[tid] = 1.f;
#endif
        if (!has_next) break;
#pragma unroll
        for (int a = 0; a < 2; ++a)
#pragma unroll
            for (int b = 0; b < 2; ++b)
#pragma unroll
                for (int m = 0; m < 4; ++m)
#pragma unroll
                    for (int n = 0; n < 2; ++n) acc[a][b][m][n] = (f32x4){0.f, 0.f, 0.f, 0.f};
        cur = nxt; cA = nA; cB = nB; ++ui;
        if (wr == 1) PG8_BAR;
    }
    PG8_WAIT_V(0);
    PG8_BAR;
#undef PG8_ABASE
#undef PG8_SA
#undef PG8_SB
#undef PG8_STAGE
#undef PG8_LDA
#undef PG8_LDB
#undef PG8_MMA
#undef PG8_WAIT_V
#undef PG8_WAIT_L
#undef PG8_BAR
#undef PG8_SCHED
}
}

#define KSWZ(row, colB) ((row) * 256 + ((colB) ^ (((row) & 7) << 4)))
#define SBAR() __builtin_amdgcn_sched_barrier(0)
__device__ __forceinline__ int crow(int r, int hi) { return (r & 3) + 8 * (r >> 2) + 4 * hi; }
__device__ __forceinline__ int v_st(int k, int c) { const int kk = (k & ~0xC) | ((k & 4) << 1) | ((k & 8) >> 1); return ((kk >> 3) * 4 + (c >> 5)) * 512 + ((kk & 7) * 32 + (c & 31)) * 2; }
__device__ __forceinline__ int v_rd_base(int lane) { return ((lane & 3) << 3) | (((lane >> 2) & 3) << 6) | (((lane >> 4) & 1) << 5) | (((lane >> 5) & 1) << 8); }
constexpr int v_rd_off(int d0, int ks, int half) { return d0 * 512 + ks * 4096 + half * 2048; }
template <int OFF> __device__ __forceinline__ s16x4 tr_read(int vb) { s16x4 r; asm volatile("ds_read_b64_tr_b16 %0, %1 offset:%2" : "=&v"(r) : "v"(vb), "i"(OFF) : "memory"); return r; }
#define PKF(L, H) (bf16x8){L[0], L[1], L[2], L[3], H[0], H[1], H[2], H[3]}
template <int D0> __device__ __forceinline__ void pv_one(f32x16& od, int vb, bf16x8 pa0, bf16x8 pa1, bf16x8 pa2, bf16x8 pa3) {
    const s16x4 l0 = tr_read<v_rd_off(D0, 0, 0)>(vb), h0 = tr_read<v_rd_off(D0, 0, 1)>(vb), l1 = tr_read<v_rd_off(D0, 1, 0)>(vb), h1 = tr_read<v_rd_off(D0, 1, 1)>(vb);
    const s16x4 l2 = tr_read<v_rd_off(D0, 2, 0)>(vb), h2 = tr_read<v_rd_off(D0, 2, 1)>(vb), l3 = tr_read<v_rd_off(D0, 3, 0)>(vb), h3 = tr_read<v_rd_off(D0, 3, 1)>(vb);
    asm volatile("s_waitcnt lgkmcnt(0)" ::: "memory"); SBAR();
    od = __builtin_amdgcn_mfma_f32_32x32x16_bf16(pa0, PKF(l0, h0), od, 0, 0, 0);
    od = __builtin_amdgcn_mfma_f32_32x32x16_bf16(pa1, PKF(l1, h1), od, 0, 0, 0);
    od = __builtin_amdgcn_mfma_f32_32x32x16_bf16(pa2, PKF(l2, h2), od, 0, 0, 0);
    od = __builtin_amdgcn_mfma_f32_32x32x16_bf16(pa3, PKF(l3, h3), od, 0, 0, 0);
}
#define PK4(P, BASE, OUT) do { unsigned a0_ = cvt_pk_bf16(P[BASE + 0], P[BASE + 1]), a1_ = cvt_pk_bf16(P[BASE + 2], P[BASE + 3]);   \
    unsigned b0_ = cvt_pk_bf16(P[BASE + 4], P[BASE + 5]), b1_ = cvt_pk_bf16(P[BASE + 6], P[BASE + 7]);                              \
    auto r0_ = __builtin_amdgcn_permlane32_swap(a0_, b0_, false, false); auto r1_ = __builtin_amdgcn_permlane32_swap(a1_, b1_, false, false); \
    u32x4 w_ = {r0_[0], r1_[0], r0_[1], r1_[1]}; OUT = *reinterpret_cast<bf16x8*>(&w_); } while (0)

namespace att {
constexpr int SHM_V = 16384, SHM_K = 16384, LDK = NIN;
constexpr float THR2 = 8.f;
#define MX3(a, b, c) __builtin_fmaxf(__builtin_fmaxf((a), (b)), (c))
__device__ __forceinline__ void partialSM(f32x16& p0, f32x16& p1, float& m_reg, float& alpha) {
    float a = MX3(p0[0], p0[1], p1[0]), b = MX3(p0[2], p0[3], p1[1]); a = MX3(a, p1[2], p1[3]);
#pragma unroll
    for (int r = 4; r < 16; r += 4) { a = MX3(a, p0[r], p0[r + 1]); b = MX3(b, p0[r + 2], p0[r + 3]); a = MX3(a, p1[r], p1[r + 1]); b = MX3(b, p1[r + 2], p1[r + 3]); }
    float pmax = fmaxf(a, b);
    { auto rr = __builtin_amdgcn_permlane32_swap(__float_as_uint(pmax), __float_as_uint(pmax), false, false); pmax = fmaxf(__uint_as_float(rr[0]), __uint_as_float(rr[1])); }
    if (__builtin_expect(__all(pmax <= THR2), 1)) { alpha = 1.f; }
    else { const float dl = fmaxf(pmax, 0.f); m_reg += dl; alpha = ex2(-dl);
#pragma unroll
        for (int r = 0; r < 16; ++r) { p0[r] -= dl; p1[r] -= dl; }
}
#pragma unroll
    for (int r = 0; r < 16; ++r) p0[r] = ex2(p0[r]);
}
__device__ __forceinline__ void finishSM(f32x16& p0, f32x16& p1, bf16x8& pa0, bf16x8& pa1, bf16x8& pa2, bf16x8& pa3) {
#pragma unroll
    for (int r = 0; r < 16; ++r) p1[r] = ex2(p1[r]);
#define PK4N(P, BASE, OUT) do { u32x4 w_ = {cvt_pk_bf16(P[BASE + 0], P[BASE + 1]), cvt_pk_bf16(P[BASE + 2], P[BASE + 3]), cvt_pk_bf16(P[BASE + 4], P[BASE + 5]), cvt_pk_bf16(P[BASE + 6], P[BASE + 7])}; OUT = *reinterpret_cast<bf16x8*>(&w_); } while (0)
    PK4N(p0, 0, pa0); PK4N(p0, 8, pa1); PK4N(p1, 0, pa2); PK4N(p1, 8, pa3);
#undef PK4N
}
template <bool ZEROC>
__device__ __forceinline__ void qkt_t(f32x16& p0, f32x16& p1, const char* Ks, const bf16x8* qr, int r32, int hi, int comp, float negm1) {
    if (!ZEROC) {
#pragma unroll
        for (int r = 0; r < 16; ++r) { p0[r] = negm1; p1[r] = negm1; } }
#pragma unroll
    for (int d0 = 0; d0 < 4; ++d0) { const int cb = ((comp * 4 + d0) * 16 + hi * 8) * 2;
        const bf16x8 b0 = *reinterpret_cast<const bf16x8*>(Ks + KSWZ(r32, cb));
        const bf16x8 b1 = *reinterpret_cast<const bf16x8*>(Ks + KSWZ(32 + r32, cb));
        if (ZEROC && d0 == 0) { p0 = __builtin_amdgcn_mfma_f32_32x32x16_bf16(b0, qr[0], f32x16{}, 0, 0, 0); p1 = __builtin_amdgcn_mfma_f32_32x32x16_bf16(b1, qr[0], f32x16{}, 0, 0, 0); }
        else { p0 = __builtin_amdgcn_mfma_f32_32x32x16_bf16(b0, qr[d0], p0, 0, 0, 0); p1 = __builtin_amdgcn_mfma_f32_32x32x16_bf16(b1, qr[d0], p1, 0, 0, 0); } }
}
#define qkt(P0, P1, KS, QR, R32, HI, COMP, NEGM) do { if (FAST) qkt_t<true>(P0, P1, KS, QR, R32, HI, COMP, 0.f); else qkt_t<false>(P0, P1, KS, QR, R32, HI, COMP, NEGM); } while (0)
__device__ __forceinline__ void pv_d0(f32x16* o, f32x16& lacc, int vb, bf16x8 pa0, bf16x8 pa1, bf16x8 pa2, bf16x8 pa3) {
    const bf16x8 ones = {0x3F80, 0x3F80, 0x3F80, 0x3F80, 0x3F80, 0x3F80, 0x3F80, 0x3F80};
    lacc = __builtin_amdgcn_mfma_f32_32x32x16_bf16(pa0, ones, lacc, 0, 0, 0); lacc = __builtin_amdgcn_mfma_f32_32x32x16_bf16(pa1, ones, lacc, 0, 0, 0);
    lacc = __builtin_amdgcn_mfma_f32_32x32x16_bf16(pa2, ones, lacc, 0, 0, 0); lacc = __builtin_amdgcn_mfma_f32_32x32x16_bf16(pa3, ones, lacc, 0, 0, 0);
    pv_one<0>(o[0], vb, pa0, pa1, pa2, pa3); pv_one<1>(o[1], vb, pa0, pa1, pa2, pa3); pv_one<2>(o[2], vb, pa0, pa1, pa2, pa3); pv_one<3>(o[3], vb, pa0, pa1, pa2, pa3);
}
__device__ __forceinline__ bool attn_unit(bf16_t* Pb, int seq, int h, int q0, float lam, float onem, const float* ag, char* lds, const bool FAST) {
    int tid = threadIdx.x; asm volatile("" : "+v"(tid));
    const int wid = tid >> 6, lane = tid & 63, r32 = lane & 31, hi = lane >> 5, comp = wid >> 2, wq = wid & 3;
    const int widu = __builtin_amdgcn_readfirstlane(wid);
    LAS char* ring = (LAS char*)lds;
    float* ws = (float*)(lds + 98304) + wid * 64; float* li_l = ws; float* al_l = ws + 32;
    const bf16_t* Kh = Pb + 1024 + h * 128; const bf16_t* Vh = Pb + 1536 + h * 128;
    float m_reg = 0.f; f32x16 o[4] = {}, lacc = {}; bf16x8 qr[4];
    int koff[2], voff[2];
#pragma unroll
    for (int i = 0; i < 2; ++i) { const int p = wid + 8 * i;
        { const int row = p * 4 + (lane >> 4), lc = ((lane & 15) * 16) ^ ((row & 7) << 4); koff[i] = row * LDK + (lc >> 1); }
        { const int st = 2 * p + (lane >> 5), kk = (st >> 2) * 8 + ((lane & 31) >> 2), c = (st & 3) * 32 + (lane & 3) * 8, k = kk; voff[i] = k * LDK + c; }     }
#define DMA_TILE(t, b) do { const bf16_t* kp_ = Kh + (size_t)(t) * 64 * LDK; const bf16_t* vp_ = Vh + (size_t)(t) * 64 * LDK; \
    _Pragma("unroll") for (int i_ = 0; i_ < 2; ++i_) { \
        __builtin_amdgcn_global_load_lds((const unsigned*)(kp_ + koff[i_]), (LAS unsigned*)(ring + (b) * 32768 + 16384 + (widu + 8 * i_) * 1024), 16, 0, 0); \
        __builtin_amdgcn_global_load_lds((const unsigned*)(vp_ + voff[i_]), (LAS unsigned*)(ring + (b) * 32768 + (widu + 8 * i_) * 1024), 16, 0, 0); } } while (0)
    DMA_TILE(0, 0); DMA_TILE(1, 1);
    const bf16_t* Qw = Pb + (size_t)(q0 + wq * 32 + r32) * LDK + h * 128 + comp * 64 + hi * 8;
#pragma unroll
    for (int d0 = 0; d0 < 4; ++d0) qr[d0] = *reinterpret_cast<const bf16x8*>(Qw + d0 * 16);
    const int vb0 = (int)(uintptr_t)lds + v_rd_base(lane);
#define RESC(a) do { if (__any((a) < 1.f)) { if (hi == 0) al_l[r32] = (a); asm volatile("s_waitcnt lgkmcnt(0)" ::: "memory"); \
    _Pragma("unroll") for (int r = 0; r < 16; ++r) { const float f_ = al_l[crow(r, hi)]; lacc[r] *= f_; _Pragma("unroll") for (int d = 0; d < 4; ++d) o[d][r] *= f_; } } } while (0)
    f32x16 pA0, pA1, pB0, pB1; float alA, alB; bf16x8 pa0, pa1, pa2, pa3; const int NT = seq / 64;
    asm volatile("s_waitcnt vmcnt(0)" ::: "memory"); __syncthreads();
    DMA_TILE(2, 2);
    qkt(pA0, pA1, lds + 16384, qr, r32, hi, comp, -m_reg); do { if (FAST) { alA = 1.f; _Pragma("unroll") for (int r_ = 0; r_ < 16; ++r_) pA0[r_] = ex2(pA0[r_]); } else partialSM(pA0, pA1, m_reg, alA); } while (0);
    int bcur = 1, bprev = 0, bnext = 2;
#define HALF(PC0, PC1, PP0, PP1, ALC, ALP, j) do { \
    SBAR(); qkt(PC0, PC1, lds + bcur * 32768 + 16384, qr, r32, hi, comp, -m_reg); \
    finishSM(PP0, PP1, pa0, pa1, pa2, pa3); SBAR(); \
    pv_d0(o, lacc, vb0 + bprev * 32768, pa0, pa1, pa2, pa3); do { if (FAST) { ALC = 1.f; _Pragma("unroll") for (int r_ = 0; r_ < 16; ++r_) PC0[r_] = ex2(PC0[r_]); } else partialSM(PC0, PC1, m_reg, ALC); } while (0); \
    asm volatile("s_waitcnt vmcnt(0)" ::: "memory"); __syncthreads();        \
    if ((j) + 2 < NT) DMA_TILE((j) + 2, bprev); \
    if (!FAST) RESC(ALC); \
    { const int t_ = bprev; bprev = bcur; bcur = bnext; bnext = t_; } } while (0)
    for (int j = 1; j + 1 < NT; j += 2) {
        HALF(pB0, pB1, pA0, pA1, alB, alA, j);
        HALF(pA0, pA1, pB0, pB1, alA, alB, j + 1);
    }
    SBAR(); qkt(pB0, pB1, lds + bcur * 32768 + 16384, qr, r32, hi, comp, -m_reg);
    finishSM(pA0, pA1, pa0, pa1, pa2, pa3); SBAR();
    pv_d0(o, lacc, vb0 + bprev * 32768, pa0, pa1, pa2, pa3); do { if (FAST) { alB = 1.f; _Pragma("unroll") for (int r_ = 0; r_ < 16; ++r_) pB0[r_] = ex2(pB0[r_]); } else partialSM(pB0, pB1, m_reg, alB); } while (0);
    if (!FAST) RESC(alB);
    finishSM(pB0, pB1, pa0, pa1, pa2, pa3); SBAR();
    pv_d0(o, lacc, vb0 + bcur * 32768, pa0, pa1, pa2, pa3);
    if (FAST) { float lm_ = 0.f, ln_ = 3.0e38f;
#pragma unroll
        for (int r = 0; r < 16; ++r) { const float v_ = lacc[r] != lacc[r] ? 3.0e38f : lacc[r]; lm_ = fmaxf(lm_, v_); ln_ = fminf(ln_, lacc[r]); }
        if (__syncthreads_or((!(lm_ < 1e30f) || !(ln_ > 1e-30f)) ? 1 : 0)) return true; }
    float rli[16];
#pragma unroll
    for (int r = 0; r < 16; ++r) rli[r] = __builtin_amdgcn_rcpf(lacc[r]);
    __syncthreads();
    float* X = (float*)lds + wq * 4096;
    if (comp == 1) {
#pragma unroll
        for (int d = 0; d < 4; ++d)
#pragma unroll
            for (int r = 0; r < 16; ++r) X[(d * 16 + r) * 64 + lane] = o[d][r] * rli[r];
    }
    __syncthreads();
    if (comp == 0) {
        float ssq[16];
#pragma unroll
        for (int r = 0; r < 16; ++r) { float a = 0.f;
#pragma unroll
            for (int d = 0; d < 4; ++d) { const float v = o[d][r] * rli[r] - lam * X[(d * 16 + r) * 64 + lane]; o[d][r] = v; a += v * v; }
            ssq[r] = a; }
#pragma unroll
        for (int r = 0; r < 16; ++r) { float a = ssq[r]; a += __shfl_xor(a, 1); a += __shfl_xor(a, 2); a += __shfl_xor(a, 4); a += __shfl_xor(a, 8); a += __shfl_xor(a, 16);
            ssq[r] = rsqrtf(a * (1.f / 128.f) + EPS) * onem; }
        float gg[4];
#pragma unroll
        for (int d = 0; d < 4; ++d) gg[d] = ag[d * 32 + r32];
        bf16_t* Ow = Pb + (size_t)(q0 + wq * 32) * LDK + h * 128;
#pragma unroll
        for (int r = 0; r < 16; ++r) { const int orow = crow(r, hi);
#pragma unroll
            for (int d = 0; d < 4; ++d) { const unsigned w = cvt_pk_bf16(o[d][r] * ssq[r] * gg[d], 0.f); Ow[(size_t)orow * LDK + d * 32 + r32] = (bf16_t)(w & 0xffffu); } }
    }
    __syncthreads();
#undef DMA_TILE
#undef HALF
#undef RESC
    return false;
}
#undef qkt
}

namespace hg {
constexpr int T_QR = 0, T_KR = 16384, T_QE = 32768, T_KE = 49152, T_V = 65536, T_ST = 81920, T_TOT = 114688, T_DL = 118784, TO_STRIDE = 132;
__device__ __forceinline__ void hgrn_unit(bf16_t* Pb, int seq, int h, int dir, char* lds) {
    int tid = threadIdx.x; asm volatile("" : "+v"(tid));
    const int wid = tid >> 6, lane = tid & 63, r32 = lane & 31, hi = lane >> 5;
    const int th = wid & 1, d0 = wid >> 1, kb = wid & 3, eb0 = 2 * (wid >> 2);
    char* QR = lds + T_QR; char* KR = lds + T_KR; char* QE = lds + T_QE; char* KE = lds + T_KE; char* VT = lds + T_V; char* ST = lds + T_ST;
    float* TOT = (float*)(lds + T_TOT); float* DL = (float*)(lds + T_DL); float* TO = (float*)lds;
    const int nch = seq / 64;
    const int qcol = 512 + h * 128, vcol = 3072 + h * 128, gcol = (dir == 0 ? 2048 : 2560) + h * 128;
    const int ot = tid >> 3, oe = (tid & 7) * 16;
    for (int i = tid; i < 2048; i += 512) ((u32x4*)ST)[i] = (u32x4){0u, 0u, 0u, 0u};
    f32x16 S0 = {}, S1 = {};
    unsigned G[8], Q[8], V[8];
#define HLOAD(GD, QD, VD, ch) do { const int c0_ = ((dir == 0) ? (ch) : (nch - 1 - (ch))) * 64; \
    _Pragma("unroll") for (int j = 0; j < 8; ++j) { const int i_ = 8 * wid + j; const int tok_ = c0_ + ((dir == 0) ? i_ : 63 - i_); \
        const bf16_t* rp_ = Pb + (size_t)tok_ * NIN + 2 * lane; GD[j] = *(const unsigned*)(rp_ + gcol); QD[j] = *(const unsigned*)(rp_ + qcol); VD[j] = *(const unsigned*)(rp_ + vcol); } } while (0)
    HLOAD(G, Q, V, 0);
    __syncthreads();
    for (int ch = 0; ch < nch; ++ch) {
        const int c0 = ((dir == 0) ? ch : (nch - 1 - ch)) * 64;
        float cs0[8], cs1[8];
#pragma unroll
        for (int j = 0; j < 8; ++j) { const float g0 = h_lo(G[j]), g1 = h_hi(G[j]); cs0[j] = (j ? cs0[j - 1] : 0.f) + g0; cs1[j] = (j ? cs1[j - 1] : 0.f) + g1; }
        *(f32x2*)(TOT + wid * 128 + 2 * lane) = (f32x2){cs0[7], cs1[7]};
        __syncthreads();
        float pre0 = 0.f, pre1 = 0.f, rf0 = 0.f, rf1 = 0.f, bl0 = 0.f, bl1 = 0.f;
#pragma unroll
        for (int w = 0; w < 8; ++w) { const f32x2 t = *(const f32x2*)(TOT + w * 128 + 2 * lane); if (w < wid) { pre0 += t.x; pre1 += t.y; } if (w < 4) { rf0 += t.x; rf1 += t.y; } bl0 += t.x; bl1 += t.y; }
        const float erf0 = ex2(rf0), erf1 = ex2(rf1), ebr0 = ex2(bl0 - rf0), ebr1 = ex2(bl1 - rf1);
#pragma unroll
        for (int j = 0; j < 8; ++j) {
            const int i = 8 * wid + j; const float b0 = pre0 + cs0[j], b1 = pre1 + cs1[j];
            const float e0 = ex2(b0 - rf0), e1 = ex2(b1 - rf1);
            const float qr0 = h_lo(Q[j]) * e0, qr1 = h_hi(Q[j]) * e1;
            const float kr0 = (1.f - ex2(h_lo(G[j]))) * __builtin_amdgcn_rcpf(e0), kr1 = (1.f - ex2(h_hi(G[j]))) * __builtin_amdgcn_rcpf(e1);
            const int ko = KSWZ(i, 4 * lane), vo = v_st(i, 2 * lane);
            *(unsigned*)(QR + ko) = cvt_pk_bf16(qr0, qr1);
            *(unsigned*)(QE + ko) = cvt_pk_bf16(qr0 * erf0, qr1 * erf1);
            *(unsigned*)(KR + ko) = cvt_pk_bf16(kr0, kr1);
            *(unsigned*)(KE + vo) = cvt_pk_bf16(kr0 * ebr0, kr1 * ebr1);
            *(unsigned*)(VT + vo) = V[j];
        }
        if (wid == 0) *(f32x2*)(DL + 2 * lane) = (f32x2){ex2(bl0), ex2(bl1)};
        __syncthreads();
        if (ch + 1 < nch) HLOAD(G, Q, V, ch + 1);
        const int otok = c0 + ((dir == 0) ? ot : 63 - ot);
        bf16_t* orow = Pb + (size_t)otok * NIN;
        f32x16 p0 = {}, p1 = {};
#pragma unroll
        for (int kd = 0; kd < 8; ++kd) { const int cb = (kd * 16 + hi * 8) * 2;
            const bf16x8 bq = *(const bf16x8*)(QR + KSWZ(th * 32 + r32, cb));
            const bf16x8 a0 = *(const bf16x8*)(KR + KSWZ(r32, cb));
            p0 = __builtin_amdgcn_mfma_f32_32x32x16_bf16(a0, bq, p0, 0, 0, 0);
            if (th) { const bf16x8 a1 = *(const bf16x8*)(KR + KSWZ(32 + r32, cb)); p1 = __builtin_amdgcn_mfma_f32_32x32x16_bf16(a1, bq, p1, 0, 0, 0); } }
#pragma unroll
        for (int r = 0; r < 16; ++r) { const bool keep = crow(r, hi) <= r32; if (th == 0) { p0[r] = keep ? p0[r] : 0.f; p1[r] = 0.f; } else { p1[r] = keep ? p1[r] : 0.f; } }
        bf16x8 pa0, pa1, pa2, pa3; PK4(p0, 0, pa0); PK4(p0, 8, pa1); PK4(p1, 0, pa2); PK4(p1, 8, pa3);
        f32x16 o = {};
        pv_one<0>(o, (int)(uintptr_t)VT + v_rd_base(lane) + d0 * 512, pa0, pa1, pa2, pa3);
#pragma unroll
        for (int kd = 0; kd < 8; ++kd) { const int cb = (kd * 16 + hi * 8) * 2;
            const bf16x8 a = *(const bf16x8*)(QE + KSWZ(th * 32 + r32, cb));
            const bf16x8 b = *(const bf16x8*)(ST + KSWZ(d0 * 32 + r32, cb));
            o = __builtin_amdgcn_mfma_f32_32x32x16_bf16(a, b, o, 0, 0, 0); }
#pragma unroll
        for (int r = 0; r < 16; ++r) { const float f = DL[kb * 32 + crow(r, hi)]; S0[r] *= f; S1[r] *= f; }
        { const int keb = (int)(uintptr_t)KE + v_rd_base(lane) + kb * 512, vbb = (int)(uintptr_t)VT + v_rd_base(lane) + eb0 * 512;
#define HSTEP(ks) do { const s16x4 kl = tr_read<v_rd_off(0, ks, 0)>(keb), kh = tr_read<v_rd_off(0, ks, 1)>(keb); \
            const s16x4 al = tr_read<v_rd_off(0, ks, 0)>(vbb), ah = tr_read<v_rd_off(0, ks, 1)>(vbb), bl_ = tr_read<v_rd_off(1, ks, 0)>(vbb), bh_ = tr_read<v_rd_off(1, ks, 1)>(vbb); \
            asm volatile("s_waitcnt lgkmcnt(0)" ::: "memory"); SBAR(); \
            S0 = __builtin_amdgcn_mfma_f32_32x32x16_bf16(PKF(kl, kh), PKF(al, ah), S0, 0, 0, 0); \
            S1 = __builtin_amdgcn_mfma_f32_32x32x16_bf16(PKF(kl, kh), PKF(bl_, bh_), S1, 0, 0, 0); } while (0)
          HSTEP(0); HSTEP(1); HSTEP(2); HSTEP(3);
#undef HSTEP
        }
        __syncthreads();
#pragma unroll
        for (int q4 = 0; q4 < 4; ++q4) { const int kc = (kb * 32 + 8 * q4 + 4 * hi) * 2;
            u32x2 w0, w1; w0.x = cvt_pk_bf16(S0[4 * q4], S0[4 * q4 + 1]); w0.y = cvt_pk_bf16(S0[4 * q4 + 2], S0[4 * q4 + 3]); w1.x = cvt_pk_bf16(S1[4 * q4], S1[4 * q4 + 1]); w1.y = cvt_pk_bf16(S1[4 * q4 + 2], S1[4 * q4 + 3]);
            *(u32x2*)(ST + KSWZ(eb0 * 32 + r32, kc)) = w0; *(u32x2*)(ST + KSWZ((eb0 + 1) * 32 + r32, kc)) = w1; }
#pragma unroll
        for (int r = 0; r < 16; ++r) TO[(th * 32 + crow(r, hi)) * TO_STRIDE + d0 * 32 + r32] = o[r];
        __syncthreads();
        { float ov[16];
#pragma unroll
          for (int i = 0; i < 4; ++i) { const f32x4 t = *(const f32x4*)(TO + ot * TO_STRIDE + oe + 4 * i); ov[4 * i] = t.x; ov[4 * i + 1] = t.y; ov[4 * i + 2] = t.z; ov[4 * i + 3] = t.w; }
          u32x4 w0, w1; w0.x = cvt_pk_f16(ov[0], ov[1]); w0.y = cvt_pk_f16(ov[2], ov[3]); w0.z = cvt_pk_f16(ov[4], ov[5]); w0.w = cvt_pk_f16(ov[6], ov[7]);
          w1.x = cvt_pk_f16(ov[8], ov[9]); w1.y = cvt_pk_f16(ov[10], ov[11]); w1.z = cvt_pk_f16(ov[12], ov[13]); w1.w = cvt_pk_f16(ov[14], ov[15]);
          *(u32x4*)(orow + gcol + oe) = w0; *(u32x4*)(orow + gcol + oe + 8) = w1; }
    }
    __threadfence(); __syncthreads();
#undef HLOAD
}
__device__ __forceinline__ void hgrn_combine(bf16_t* Pb, int seq, int h, const float* hgg) {
    int tid = threadIdx.x; asm volatile("" : "+v"(tid));
    const int ot = tid >> 3, oe = (tid & 7) * 16;
    float gh[16];
#pragma unroll
    for (int i = 0; i < 16; ++i) gh[i] = hgg[oe + i];
    for (int r0 = 0; r0 < seq; r0 += 64) {
        bf16_t* orow = Pb + (size_t)(r0 + ot) * NIN + h * 128 + oe;
        const u32x4 f0 = __builtin_nontemporal_load((const u32x4*)(orow + 2048)), f1 = __builtin_nontemporal_load((const u32x4*)(orow + 2048 + 8));
        const u32x4 b0 = __builtin_nontemporal_load((const u32x4*)(orow + 2560)), b1 = __builtin_nontemporal_load((const u32x4*)(orow + 2560 + 8));
        const u32x4 g0 = *(const u32x4*)(orow + 3584), g1 = *(const u32x4*)(orow + 3584 + 8);
        const unsigned fw[8] = {f0.x, f0.y, f0.z, f0.w, f1.x, f1.y, f1.z, f1.w}, bw[8] = {b0.x, b0.y, b0.z, b0.w, b1.x, b1.y, b1.z, b1.w}, gw[8] = {g0.x, g0.y, g0.z, g0.w, g1.x, g1.y, g1.z, g1.w};
        float ov[16], ss = 0.f;
#pragma unroll
        for (int i = 0; i < 8; ++i) { ov[2 * i] = h_lo(fw[i]) + h_lo(bw[i]); ov[2 * i + 1] = h_hi(fw[i]) + h_hi(bw[i]); ss += ov[2 * i] * ov[2 * i] + ov[2 * i + 1] * ov[2 * i + 1]; }
        ss += __shfl_xor(ss, 1); ss += __shfl_xor(ss, 2); ss += __shfl_xor(ss, 4);
        const float rr = rsqrtf(ss * (1.f / 128.f) + EPS);
        unsigned wv[8];
#pragma unroll
        for (int i = 0; i < 8; ++i) wv[i] = cvt_pk_bf16(ov[2 * i] * rr * gh[2 * i] * h_lo(gw[i]), ov[2 * i + 1] * rr * gh[2 * i + 1] * h_hi(gw[i]));
        *(u32x4*)(orow + 512) = (u32x4){wv[0], wv[1], wv[2], wv[3]}; *(u32x4*)(orow + 512 + 8) = (u32x4){wv[4], wv[5], wv[6], wv[7]};
    }
}
}

__device__ __forceinline__ void prep_weight_item(const float* W, int K, int N, int n0, bf16_t* WT, int drow0, const float* g, const float* b, float* c1, float* c2, LAS float* scr, int lane, int kbeg, int kend) {
    float c1a[4] = {0.f, 0.f, 0.f, 0.f}, c2a[4] = {0.f, 0.f, 0.f, 0.f};
    const int c = lane & 7;
    for (int k0 = kbeg; k0 < kend; k0 += 64) {
#pragma unroll 8
        for (int i = 0; i < 32; ++i) { const int kk = 2 * i + (lane >> 5); scr[kk * 33 + (lane & 31)] = W[(size_t)(k0 + kk) * N + n0 + (lane & 31)]; }
        asm volatile("s_waitcnt lgkmcnt(0)" ::: "memory");
        float gk[8], bk[8];
#pragma unroll
        for (int i = 0; i < 8; ++i) { gk[i] = g ? g[k0 + 8 * c + i] : 1.f; bk[i] = b ? b[k0 + 8 * c + i] : 0.f; }
#pragma unroll
        for (int j = 0; j < 4; ++j) { const int n = (lane >> 3) + 8 * j; const LAS float* s = scr + (8 * c) * 33 + n;
            float w[8];
#pragma unroll
            for (int i = 0; i < 8; ++i) w[i] = s[i * 33];
            u32x4 o; o.x = cvt_pk_bf16(w[0] * gk[0], w[1] * gk[1]); o.y = cvt_pk_bf16(w[2] * gk[2], w[3] * gk[3]); o.z = cvt_pk_bf16(w[4] * gk[4], w[5] * gk[5]); o.w = cvt_pk_bf16(w[6] * gk[6], w[7] * gk[7]);
            c1a[j] += ((bf_lo(o.x) + bf_hi(o.x)) + (bf_lo(o.y) + bf_hi(o.y))) + ((bf_lo(o.z) + bf_hi(o.z)) + (bf_lo(o.w) + bf_hi(o.w)));
#pragma unroll
            for (int i = 0; i < 8; ++i) c2a[j] += bk[i] * w[i];
            *(u32x4*)(WT + (size_t)(drow0 + n) * K + k0 + 8 * c) = o; }
        asm volatile("s_waitcnt lgkmcnt(0)" ::: "memory");
    }
    if (c1) {
#pragma unroll
        for (int j = 0; j < 4; ++j) { float a = c1a[j], d = c2a[j]; a += __shfl_xor(a, 1); a += __shfl_xor(a, 2); a += __shfl_xor(a, 4); d += __shfl_xor(d, 1); d += __shfl_xor(d, 2); d += __shfl_xor(d, 4);
            if (c == 0) { const int n = (lane >> 3) + 8 * j; c1[drow0 + n] = a; c2[drow0 + n] = d; } }
    }
}

#define XB_TMO      128
#define XB_XCNT(j)  (256  + 64 * (j))
#define XB_XSUB(j)  (1280 + 64 * (j))
#define XB_XGEN(j)  (2304 + 64 * (j))
#define XB_TOP      3328
#define XB_TOPGEN   3392
#define XCD_BAR_WORDS 3456
#define XB_SPIN_CAP (1u << 18)

__device__ __forceinline__ unsigned xb_ld(unsigned* p)              { return __hip_atomic_load(p, __ATOMIC_RELAXED, __HIP_MEMORY_SCOPE_AGENT); }
__device__ __forceinline__ unsigned xb_add(unsigned* p, unsigned v) { return __hip_atomic_fetch_add(p, v, __ATOMIC_RELAXED, __HIP_MEMORY_SCOPE_AGENT); }
__device__ __forceinline__ unsigned xb_xcc_id() { return (unsigned)__builtin_amdgcn_s_getreg((3 << 11) | 20) & 0xFu; }
#define XB_SPIN(cond, bar) do { unsigned _sp = 0; while (cond) { __builtin_amdgcn_s_sleep(1); \
    if ((++_sp & 255u) == 0u) { if (xb_ld(&(bar)[XB_TMO])) break; if (_sp > XB_SPIN_CAP) { atomicAdd(&(bar)[XB_TMO], 1u); break; } } } } while (0)

struct XcdBarrier {
    unsigned* bar; unsigned x;
    volatile LAS unsigned* st;
};

__device__ __forceinline__ XcdBarrier xcd_barrier_post(unsigned* bar, volatile LAS unsigned* st) {
    XcdBarrier b; b.bar = bar; b.x = xb_xcc_id(); b.st = st;
    if (threadIdx.x == 0) (void)xb_add(&bar[XB_XCNT(b.x)], 1u);
    return b;
}
__device__ __forceinline__ void xcd_barrier_complete(unsigned* bar, unsigned x, unsigned& nloc, unsigned& nx) {
    const unsigned G = gridDim.x * gridDim.y * gridDim.z;
    unsigned sum, cnt, mine, sp = 0u;
    for (;;) {
        sum = 0u; cnt = 0u; mine = 0u;
#pragma unroll
        for (unsigned j = 0; j < 16; ++j) { const unsigned c = xb_ld(&bar[XB_XCNT(j)]); sum += c; cnt += (c > 0u) ? 1u : 0u; mine = (j == x) ? c : mine; }
        if (sum == G) break;
        __builtin_amdgcn_s_sleep(1);
        if ((++sp & 255u) == 0u) { if (xb_ld(&bar[XB_TMO])) break; if (sp > XB_SPIN_CAP) { atomicAdd(&bar[XB_TMO], 1u); break; } }
    }
    nloc = mine > 0u ? mine : 1u; nx = cnt > 0u ? cnt : 1u;
}

__device__ __forceinline__ void xcd_barrier(const XcdBarrier& b) {
    asm volatile("s_waitcnt vmcnt(0)" ::: "memory");
    __syncthreads();
    if (threadIdx.x == 0) {
        unsigned* bar = b.bar;
        __builtin_amdgcn_s_waitcnt(0);
        unsigned nloc = b.st[0], nx = b.st[1];
        if (nloc == 0u) { xcd_barrier_complete(bar, b.x, nloc, nx); b.st[0] = nloc; b.st[1] = nx; }
        const unsigned old = xb_add(&bar[XB_XSUB(b.x)], 1u);
        const unsigned gen = old / nloc;
        if (old + 1u == (gen + 1u) * nloc) {
            __builtin_amdgcn_fence(__ATOMIC_RELEASE, "agent");
            asm volatile("s_waitcnt vmcnt(0)" ::: "memory");
            const unsigned og = xb_add(&bar[XB_TOP], 1u);
            const unsigned tg = og / nx;
            if (og + 1u == (tg + 1u) * nx) xb_add(&bar[XB_TOPGEN], 1u);
            else XB_SPIN(xb_ld(&bar[XB_TOPGEN]) == tg, bar);
            __builtin_amdgcn_fence(__ATOMIC_ACQUIRE, "agent");
            xb_add(&bar[XB_XGEN(b.x)], 1u);
            asm volatile("s_waitcnt vmcnt(0)" ::: "memory");
        } else {
            XB_SPIN(xb_ld(&bar[XB_XGEN(b.x)]) == gen, bar);
            __builtin_amdgcn_fence(__ATOMIC_ACQUIRE, "agent");
            asm volatile("s_waitcnt vmcnt(0)" ::: "memory");
        }
    }
    __syncthreads();
}


constexpr int NWAVES = 8, LDS_BYTES = 147456, MISC_OFF = 131072;
constexpr int N_PHASES = 16;
struct Args { const float* in[13]; float* out; unsigned char* ws; int ph_lo, ph_hi; };

__global__ void __launch_bounds__(NWAVES * 64, 2) fwd_kernel(Args a) {
    extern __shared__ __attribute__((aligned(16))) unsigned char lds[];
    LAS unsigned char* ldsl = (LAS unsigned char*)lds;
    const int G = gridDim.x, bx = blockIdx.x;
    unsigned char* ws = a.ws;
    unsigned* ctl = (unsigned*)(ws + WS_CTL); float* lamv = (float*)(ws + WS_CTL + 1024); float* LB = (float*)(ws + WS_CTL + 4096);
    float* stats = (float*)(ws + WS_STATS); float* rope = (float*)(ws + WS_ROPE); float* vec = (float*)(ws + WS_VEC);
    bf16_t* Wgu = (bf16_t*)(ws + WS_WGU); bf16_t* Wd = (bf16_t*)(ws + WS_WD); bf16_t* Win = (bf16_t*)(ws + WS_WIN); bf16_t* Wout = (bf16_t*)(ws + WS_WOUT);
    bf16_t* Z = (bf16_t*)(ws + WS_Z); bf16_t* BIG0 = (bf16_t*)a.out; bf16_t* BIG1 = (bf16_t*)(ws + WS_BIGS);
    const float* ln_g = (const float*)(ws + WS_CTL + 65536); const float* ln_b = ln_g + 6144; const float* attn_g = ln_g + 12288; const float* hg_g = ln_g + 12544;
    cg::grid_group grid = cg::this_grid();
    const int lo = a.ph_lo, hi = a.ph_hi;

    int ph = lo;
    if (ph == 0) {
        int tid = threadIdx.x; asm volatile("" : "+v"(tid));
        const int lane = tid & 63, wave = __builtin_amdgcn_readfirstlane(tid >> 6);
        {
            const float* ln_g = a.in[11]; const float* ln_b = a.in[12];
#ifndef SKIP_PRO
            const int gw = bx * NWAVES + wave, NGW = G * NWAVES, gt = bx * 512 + tid, NGT = G * 512;
            LAS float* scr = (LAS float*)(ldsl + wave * 16384);
            for (int it = gw; it < 1536; it += NGW) {
                int r = it;
                if (r < 512) { const int kq = r & 3, r4 = r >> 2, fi = r4 >> 5, nb = r4 & 31; prep_weight_item(a.in[10] + (size_t)fi * DFF * DM, DFF, DM, nb * 32, Wd + (size_t)fi * DM * DFF, nb * 32, nullptr, nullptr, nullptr, nullptr, scr, lane, kq * 704, kq * 704 + 704); continue; }
                r -= 512;
                if (r < 704) { const int fi = r / 176, r2 = r % 176, which = r2 / 88, nb = r2 % 88, n0 = nb * 32;
                    const int lni = (fi == 0) ? -1 : (fi == 1) ? 1 : (fi == 2) ? 2 : 4;
                    prep_weight_item((which ? a.in[9] : a.in[8]) + (size_t)fi * DM * DFF, DM, DFF, n0, Wgu + (size_t)fi * NGU * DM, 256 * (n0 >> 7) + 128 * which + (n0 & 127),
                                     lni < 0 ? nullptr : ln_g + lni * DM, lni < 0 ? nullptr : ln_b + lni * DM, vec + V_C1GU + fi * NGU, vec + V_C2GU + fi * NGU, scr, lane, 0, DM); continue; }
                r -= 704;
                if (r < 256) { const int l = r >> 7, nb = r & 127, n0 = nb * 32, sg = n0 >> 9; const int dg = (sg == 1) ? 2 : (sg == 2) ? 3 : (sg == 3) ? 1 : sg; const int lni = l ? 3 : 0;
                    prep_weight_item(a.in[2] + (size_t)l * DM * NIN, DM, NIN, n0, Win + (size_t)l * NIN * DM, dg * 512 + (n0 & 511), ln_g + lni * DM, ln_b + lni * DM, vec + V_C1IN + l * NIN, vec + V_C2IN + l * NIN, scr, lane, 0, DM); continue; }
                r -= 256;
                { const int l = r >> 5, nb = r & 31; prep_weight_item(a.in[3] + (size_t)l * DM * DM, DM, DM, nb * 32, Wout + (size_t)l * DM * DM, nb * 32, nullptr, nullptr, nullptr, nullptr, scr, lane, 0, DM); }
            }
            for (int m = gw; m < MTOK; m += 2 * NGW) {
                const int m2 = (m + NGW < MTOK) ? m + NGW : m;
                const float* xr = (m < MP) ? a.in[0] + (size_t)m * DM : a.in[1] + (size_t)(m - MP) * DM;
                const float* xr2 = (m2 < MP) ? a.in[0] + (size_t)m2 * DM : a.in[1] + (size_t)(m2 - MP) * DM;
                f32x4 va[4], vb[4];
#pragma unroll
                for (int j = 0; j < 4; ++j) { va[j] = *((const f32x4*)xr + lane + 64 * j); vb[j] = *((const f32x4*)xr2 + lane + 64 * j); }
                u32x2* o8 = (u32x2*)(Z + (size_t)m * DM) + lane; u32x2* o82 = (u32x2*)(Z + (size_t)m2 * DM) + lane;
#pragma unroll
                for (int j = 0; j < 4; ++j) { u32x2 w; w.x = cvt_pk_bf16(va[j].x, va[j].y); w.y = cvt_pk_bf16(va[j].z, va[j].w); o8[64 * j] = w;
                    u32x2 w2; w2.x = cvt_pk_bf16(vb[j].x, vb[j].y); w2.y = cvt_pk_bf16(vb[j].z, vb[j].w); o82[64 * j] = w2; }
            }
            for (int i = gt; i < 8192 * 8; i += NGT) { const int pos = i >> 3, d = i & 7; const double inv = d == 0 ? 1 : d == 1 ? 0.1939227447486857733425 : d == 2 ? 0.0376060309308639356812 : d == 3 ? 0.0072926647372171090477 : d == 4 ? 0.0014142135623730950488 : d == 5 ? 0.0002742481756762073182 : d == 6 ? 0.0000531829589694498861 : 0.0000103133853772124588; const double ang = (double)pos * inv;
                double r = ang - 6.283185307179586476925 * __builtin_rint(ang * 0.15915494309189533577); const double y = r * 0.25, y2 = y * y;
                double sn = y * (1.0 + y2 * (-1.0 / 6 + y2 * (1.0 / 120 + y2 * (-1.0 / 5040 + y2 * (1.0 / 362880 + y2 * (-1.0 / 39916800 + y2 * (1.0 / 6227020800.0)))))));
                double cs = 1.0 + y2 * (-0.5 + y2 * (1.0 / 24 + y2 * (-1.0 / 720 + y2 * (1.0 / 40320 + y2 * (-1.0 / 3628800 + y2 * (1.0 / 479001600.0 + y2 * (-1.0 / 87178291200.0)))))));
                { const double s2 = 2.0 * sn * cs, c2 = 1.0 - 2.0 * sn * sn; sn = 2.0 * s2 * c2; cs = 1.0 - 2.0 * s2 * s2; }
                rope[pos * 16 + d] = (float)cs; rope[pos * 16 + 8 + d] = (float)sn; }
            if (gt < 1024) { const int dir = gt >> 9, c = gt & 511; const float x0 = a.in[7][(dir * 2 + 0) * 512 + c], x1 = a.in[7][(dir * 2 + 1) * 512 + c];
                LB[(dir * 2 + 0) * 512 + c] = 0.f; LB[(dir * 2 + 1) * 512 + c] = 1.f / (1.f + expf(x0 - x1)); }
            if (gt < 2) { const float* lp = a.in[4] + gt * 256; float s01 = 0.f, s23 = 0.f; for (int i = 0; i < 64; ++i) { s01 += lp[i] * lp[64 + i]; s23 += lp[128 + i] * lp[192 + i]; }
                const float li = 0.8f - 0.6f * expf(-0.3f * (float)gt); lamv[gt] = expf(s01) - expf(s23) + li; lamv[2 + gt] = 1.f - li; }
            if (gt < 256) ctl[gt] = 0u;
            for (int i = gt; i < XCD_BAR_WORDS; i += NGT) ((unsigned*)(ws + WS_CTL + 131072))[i] = 0u;
            { float* prm = (float*)(ws + WS_CTL + 65536);
              for (int i = gt; i < 6144; i += NGT) { prm[i] = ln_g[i]; prm[6144 + i] = ln_b[i]; }
              if (gt < 256) { prm[12288 + gt] = a.in[5][gt]; prm[12544 + gt] = a.in[6][gt]; } }
#endif
        }
        ++ph; if (ph < hi) grid.sync();
    }
    { int t_ = threadIdx.x; asm volatile("" : "+v"(t_)); if (t_ < 2) ((volatile LAS unsigned*)(ldsl + MISC_OFF + 64))[t_] = 0u; }
    __syncthreads();
    const XcdBarrier xbar = xcd_barrier_post((unsigned*)(ws + WS_CTL + 131072), (volatile LAS unsigned*)(ldsl + MISC_OFF + 64));
    bool first = true;
    for (; ph < hi; ++ph) {
        if (!first) xcd_barrier(xbar);
        first = false;
        int tid = threadIdx.x; asm volatile("" : "+v"(tid));
        const int lane = tid & 63, wave = __builtin_amdgcn_readfirstlane(tid >> 6);
        if (ph == N_PHASES - 1) {
            const int gw = bx * NWAVES + wave, NGW = G * NWAVES; const float* st = stats + 1 * STAT_STRIDE; const float* gg = ln_g + 5 * DM; const float* bb = ln_b + 5 * DM;
            for (int m = gw; m < MTOK; m += 2 * NGW) {
                const int m2 = (m + NGW < MTOK) ? m + NGW : m;
                const u32x2* zr = (const u32x2*)(Z + (size_t)m * DM) + lane; const u32x2* zr2 = (const u32x2*)(Z + (size_t)m2 * DM) + lane;
                u32x2 wa[4], wb[4];
#pragma unroll
                for (int j = 0; j < 4; ++j) { wa[j] = zr[64 * j]; wb[j] = zr2[64 * j]; }
                float mu, rs, mu2, rs2; row_stat(st, m, lane >> 4, mu, rs); row_stat(st, m2, lane >> 4, mu2, rs2);
                f32x4* orow = (f32x4*)(a.out + (size_t)m * DM) + lane; f32x4* orow2 = (f32x4*)(a.out + (size_t)m2 * DM) + lane;
#pragma unroll
                for (int j = 0; j < 4; ++j) { const f32x4 gv = *((const f32x4*)gg + lane + 64 * j), bv = *((const f32x4*)bb + lane + 64 * j);
                    const f32x4 v = {bf_lo(wa[j].x), bf_hi(wa[j].x), bf_lo(wa[j].y), bf_hi(wa[j].y)}, v2 = {bf_lo(wb[j].x), bf_hi(wb[j].x), bf_lo(wb[j].y), bf_hi(wb[j].y)};
                    orow[64 * j] = (v - mu) * rs * gv + bv; orow2[64 * j] = (v2 - mu2) * rs2 * gv + bv; } }
        } else {
            const int l = (ph - 1) / 7, sub = (ph - 1) % 7;
            if (sub == 0 || sub == 5) {
                const int s = 3 * l + (sub == 0 ? 0 : 2), fi = 2 * l + (sub == 0 ? 0 : 1);
                pg8::Gemm g{Z, Z + (size_t)MP * DM, DM, Wgu + (size_t)fi * NGU * DM, MTOK, NGU, DM}; pg8::StaticOrder S; S.init(MTOK, NGU, G, bx);
                pg8::EpiSwiGLU E{BIG0, BIG1, s == 0 ? nullptr : stats + ((s - 1) & 1) * STAT_STRIDE, vec + V_C1GU + fi * NGU, vec + V_C2GU + fi * NGU};

#ifndef SKIP_G1
                pg8::gemm_phase<pg8::EpiSwiGLU>(ldsl, g, S, E);
#endif

            } else if (sub == 1 || sub == 6) {
                const int s = 3 * l + (sub == 1 ? 0 : 2), fi = 2 * l + (sub == 1 ? 0 : 1);
                pg8::Gemm g{BIG0, BIG1, DFF, Wd + (size_t)fi * DM * DFF, MTOK, DM, DFF}; pg8::StaticOrder S; S.init(MTOK, DM, G, bx);
                pg8::EpiResid E{Z, s == 0 ? nullptr : stats + ((s - 1) & 1) * STAT_STRIDE, s == 0 ? nullptr : ln_g + (s - 1) * DM, s == 0 ? nullptr : ln_b + (s - 1) * DM, stats + (s & 1) * STAT_STRIDE, 0.5f};

#ifndef SKIP_G2
                pg8::gemm_phase<pg8::EpiResid>(ldsl, g, S, E);
#endif
            } else if (sub == 2) {
                const int s = 3 * l + 1;
                pg8::Gemm g{Z, Z + (size_t)MP * DM, DM, Win + (size_t)l * NIN * DM, MTOK, NIN, DM}; pg8::StaticOrder S; S.init(MTOK, NIN, G, bx);
                pg8::EpiProj E{BIG0, BIG1, stats + ((s - 1) & 1) * STAT_STRIDE, vec + V_C1IN + l * NIN, vec + V_C2IN + l * NIN, rope, LB + (0 * 2 + l) * 512, LB + (1 * 2 + l) * 512};

#ifndef SKIP_G3
                pg8::gemm_phase<pg8::EpiProj>(ldsl, g, S, E);
#endif

            } else if (sub == 3) {
                volatile unsigned* misc = (volatile unsigned*)(lds + MISC_OFF);
                const float lam = lamv[l], onem = lamv[2 + l];
                const int myx = (int)(__builtin_amdgcn_s_getreg((3 << 11) | 20) & 7u);
                for (int qi = 0; qi < 8; ++qi) {
                    const int x = (myx + qi) & 7;
                    for (;;) {
                        __syncthreads();
                        if (tid == 0) misc[0] = atomicAdd(ctl + l * 8 + x, 1u);
                        __syncthreads();
                        const int it = (int)misc[0];
                        if (it >= 268) break;
#ifndef SKIP_HG
                        if (it < 12) {
                            const bool smp = it < 4; const int p = smp ? 2 * x + (it >> 1) : 4 * x + ((it - 4) >> 1), dir = it & 1, b = p >> 2, h = p & 3, seq = smp ? 8192 : 4096;
                            bf16_t* Pb = smp ? BIG1 + (size_t)b * 8192 * NIN : BIG0 + (size_t)b * 4096 * NIN;
                            hg::hgrn_unit(Pb, seq, h, dir, (char*)lds);
                            if (tid == 0) misc[1] = atomicAdd(ctl + 64 + l * 48 + (smp ? p : 16 + p), 1u);
                            __syncthreads();
                            if (misc[1] == 1u) { __threadfence(); hg::hgrn_combine(Pb, seq, h, hg_g + l * 128); }
                        }
#endif
#ifndef SKIP_ATT
                        if (it >= 12) {
                            const bool smp = it < 140; const int j = smp ? it - 12 : it - 140, bh = smp ? 2 * x + (j >> 6) : 4 * x + (j >> 5), qb = smp ? (j & 63) : (j & 31), seq = smp ? 8192 : 4096;
                            bf16_t* Pb = smp ? BIG1 + (size_t)(bh >> 2) * 8192 * NIN : BIG0 + (size_t)(bh >> 2) * 4096 * NIN;
                            int fastv = 1;
                            for (;;) {
                                asm volatile("" : "+s"(fastv));
                                const bool bad = att::attn_unit(Pb, seq, bh & 3, qb * 128, lam, onem, attn_g + l * 128, (char*)lds, fastv != 0);
                                if (!bad) break;
                                fastv = 0;
                            }
                        }
#endif
                    }
                }
            } else {
                const int s = 3 * l + 1;
                pg8::Gemm g{BIG0, BIG1, NIN, Wout + (size_t)l * DM * DM, MTOK, DM, DM}; pg8::StaticOrder S; S.init(MTOK, DM, G, bx);
                pg8::EpiResid E{Z, stats + ((s - 1) & 1) * STAT_STRIDE, ln_g + (s - 1) * DM, ln_b + (s - 1) * DM, stats + (s & 1) * STAT_STRIDE, 1.0f};

#ifndef SKIP_G4
                pg8::gemm_phase<pg8::EpiResid>(ldsl, g, S, E);
#endif
            }
        }
    }
}

#ifndef MK_ONE_LAUNCH
#define MK_ONE_LAUNCH 1
#endif
extern "C" void kernel_launch(void* const* d_in, const int* in_sizes, int n_in, void* d_out, int out_size, void* d_ws, size_t ws_size, hipStream_t stream) {
    static int grid = 0;
    if (grid == 0) {
        if (n_in != 13 || out_size != MTOK * DM || ws_size < WS_END) { fprintf(stderr, "kernel_launch: unexpected shapes (n_in %d out %d ws %zu)\n", n_in, out_size, ws_size); grid = -1; return; }
        if (hipFuncSetAttribute((const void*)fwd_kernel, hipFuncAttributeMaxDynamicSharedMemorySize, LDS_BYTES) != hipSuccess) { fprintf(stderr, "kernel_launch: hipFuncSetAttribute failed\n"); grid = -1; return; }
        int dev = 0, cus = 0, per_cu = 0;
        hipGetDevice(&dev); hipDeviceGetAttribute(&cus, hipDeviceAttributeMultiprocessorCount, dev);
        hipOccupancyMaxActiveBlocksPerMultiprocessor(&per_cu, (const void*)fwd_kernel, NWAVES * 64, LDS_BYTES);
        if (per_cu < 1) { fprintf(stderr, "kernel_launch: occupancy query returned %d\n", per_cu); per_cu = 1; }
        (void)hipGetLastError();
        grid = cus * 1;
    }
    if (grid < 0) return;
    Args a{};
    for (int i = 0; i < 13; ++i) a.in[i] = (const float*)d_in[i];
    a.out = (float*)d_out; a.ws = (unsigned char*)d_ws;
#if MK_ONE_LAUNCH
    a.ph_lo = 0; a.ph_hi = N_PHASES;
    void* args[] = {&a};
    hipError_t e = hipLaunchCooperativeKernel((const void*)fwd_kernel, dim3(grid), dim3(NWAVES * 64), args, LDS_BYTES, stream);
    if (e != hipSuccess) fprintf(stderr, "cooperative launch failed: %s (grid %d)\n", hipGetErrorString(e), grid);
#else
    for (int p = 0; p < N_PHASES; ++p) { a.ph_lo = p; a.ph_hi = p + 1; hipLaunchKernelGGL(fwd_kernel, dim3(grid), dim3(NWAVES * 64), LDS_BYTES, stream, a); }
#endif
}
```

```cpp
#include <hip/hip_runtime.h>
#include <hip/hip_cooperative_groups.h>
#include <cstdio>
#include <cstdint>
namespace cg = cooperative_groups;

#define LAS __attribute__((address_space(3)))
typedef unsigned short bf16_t;
typedef short bf16x8 __attribute__((ext_vector_type(8)));
typedef short s16x4 __attribute__((ext_vector_type(4)));
typedef float f32x4 __attribute__((ext_vector_type(4)));
typedef float f32x2 __attribute__((ext_vector_type(2)));
typedef float f32x16 __attribute__((ext_vector_type(16)));
typedef unsigned u32x4 __attribute__((ext_vector_type(4)));
typedef unsigned u32x2 __attribute__((ext_vector_type(2)));

constexpr int DM = 1024, MTOK = 65536, MP = 32768, DFF = 2816, NGU = 5632, NIN = 4096;
constexpr float ALPHA = 1.4142135623730951f, EPS = 1e-5f, LOG2E = 1.4426950408889634f;
constexpr float QSCALE = 0.125f * 1.4426950408889634f;
constexpr size_t MiB = 1u << 20;
constexpr size_t WS_CTL = 0;
constexpr size_t WS_STATS = 480 * MiB;
constexpr size_t WS_ROPE = 4 * MiB;
constexpr size_t WS_VEC = 5 * MiB;
constexpr size_t WS_WGU = 6 * MiB, WS_WD = 50 * MiB, WS_WIN = 72 * MiB, WS_WOUT = 88 * MiB;
constexpr size_t WS_Z = 96 * MiB, WS_BIGS = 224 * MiB, WS_END = 496 * MiB;
constexpr size_t STAT_STRIDE = (size_t)MTOK * 32;
constexpr int V_C1GU = 0, V_C2GU = 4 * NGU, V_C1IN = 8 * NGU, V_C2IN = 8 * NGU + 2 * NIN;

typedef __bf16 bf16x2_t __attribute__((ext_vector_type(2)));
__device__ __forceinline__ unsigned cvt_pk_bf16(float lo, float hi) { const f32x2 v = {lo, hi}; const bf16x2_t b = __builtin_convertvector(v, bf16x2_t); return __builtin_bit_cast(unsigned, b); }
typedef _Float16 h16x2_t __attribute__((ext_vector_type(2)));
__device__ __forceinline__ unsigned cvt_pk_f16(float lo, float hi) { const f32x2 v = {lo, hi}; const h16x2_t b = __builtin_convertvector(v, h16x2_t); return __builtin_bit_cast(unsigned, b); }
__device__ __forceinline__ float h_lo(unsigned u) { return (float)__builtin_bit_cast(h16x2_t, u)[0]; }
__device__ __forceinline__ float h_hi(unsigned u) { return (float)__builtin_bit_cast(h16x2_t, u)[1]; }
__device__ __forceinline__ float bf_lo(unsigned u) { return __uint_as_float(u << 16); }
__device__ __forceinline__ float bf_hi(unsigned u) { return __uint_as_float(u & 0xffff0000u); }
__device__ __forceinline__ float ex2(float x) { return __builtin_amdgcn_exp2f(x); }
__device__ __forceinline__ float silu_f(float x) { return x * __builtin_amdgcn_rcpf(1.f + ex2(-x * LOG2E)); }
__device__ __forceinline__ void row_stat(const float* st, int row, int fq, float& mu, float& rs) {
    if (!st) { mu = 0.f; rs = 1.f; return; }
    const float* p = st + (size_t)row * 32 + fq * 8;
    const f32x4 a = *(const f32x4*)p, b = *(const f32x4*)(p + 4);
    float s = (a.x + a.z) + (b.x + b.z), ss = (a.y + a.w) + (b.y + b.w);
    s += __shfl_xor(s, 16); s += __shfl_xor(s, 32); ss += __shfl_xor(ss, 16); ss += __shfl_xor(ss, 32);
    mu = s * (1.f / DM); const float var = ss * (1.f / DM) - mu * mu; rs = rsqrtf(fmaxf(var, 0.f) + EPS);
}

namespace pg8 {
constexpr int BM = 256, BK = 64, HALF = 128, HTB = HALF * BK * 2, STAGE_BYTES = 8 * HTB, NXCD = 8, WGM = 8;
__host__ __device__ __forceinline__ int lds_byte(int r, int c) { const int st = (r >> 4) * 2 + (c >> 5), rr = r & 15, cc = c & 31, ob = rr * 64 + cc * 2; return st * 1024 + (ob ^ (((ob >> 9) & 1) << 5)); }
__host__ __device__ __forceinline__ void stage_rc(int b, int& R, int& C) { const int st = b / 1024, sb = b % 1024, swz = sb ^ (((sb >> 9) & 1) << 5); R = (st >> 1) * 16 + swz / 64; C = (st & 1) * 32 + (swz % 64) / 2; }
__host__ __device__ __forceinline__ int perm32(int rho) { const int n = rho >> 4, i = rho & 15; return 8 * (i >> 2) + 4 * n + (i & 3); }
struct Unit { int pm, pn; };
struct Gemm { const bf16_t* A0; const bf16_t* A1; int lda; const bf16_t* Bt; int M, N, K; };
struct StaticOrder {
    int nM, nN, nwg, G, c;
    __host__ __device__ void init(int M, int N, int G_, int c_) { nM = M / BM; nN = N / BM; nwg = nM * nN; G = G_; c = c_; }
    __host__ __device__ bool next(int i, Unit& u) const {
        const long L = (long)i * G + c; if (L >= nwg) return false;
        int wgid = (int)L; { const int q = nwg / NXCD, r = nwg % NXCD, xcd = wgid % NXCD, off = wgid / NXCD; wgid = (xcd < r ? xcd * (q + 1) : r * (q + 1) + (xcd - r) * q) + off; }
        const int nig = WGM * nN, gid = wgid / nig, fm = gid * WGM, gsz = (nM - fm) < WGM ? (nM - fm) : WGM;
        u.pm = fm + ((wgid % nig) % gsz); u.pn = (wgid % nig) / gsz; return true;
    }
};

struct EpiSwiGLU {
    static constexpr bool PERM = true;
    bf16_t* H0; bf16_t* H1; const float* st; const float* c1; const float* c2;
    __device__ __forceinline__ const float* stat_ptr() const { return st; }
    __device__ __forceinline__ const float* v1_ptr() const { return c1; }
    __device__ __forceinline__ const float* v2_ptr() const { return c2; }
    __device__ __forceinline__ void operator()(const f32x4 (&acc)[2][2][4][2], const Unit& u, int wr, int wc, int fr, int fq, const LAS f32x2* S, const LAS float* C) const {
        const int colw = wc * 32 + 8 * fq, cb = u.pn * 256 + colw;
#pragma unroll
        for (int ai = 0; ai < 2; ++ai)
#pragma unroll
            for (int m = 0; m < 4; ++m) {
                const int row = u.pm * 256 + ai * 128 + wr * 64 + m * 16 + fr; const f32x2 sr_ = S[ai * 128 + wr * 64 + m * 16 + fr]; const float mu = sr_.x, rs = sr_.y;
                bf16_t* rowp = (row < MP ? H0 + (size_t)row * DFF : H1 + (size_t)(row - MP) * DFF) + u.pn * 128 + colw;
                unsigned wv[4];
#pragma unroll
                for (int n = 0; n < 2; ++n) {
                    const f32x4 c1g = *(const LAS f32x4*)(C + colw + 4 * n), c1u = *(const LAS f32x4*)(C + colw + 128 + 4 * n), c2g = *(const LAS f32x4*)(C + 256 + colw + 4 * n), c2u = *(const LAS f32x4*)(C + 256 + colw + 128 + 4 * n);
                    float hv[4];
#pragma unroll
                    for (int j = 0; j < 4; ++j) {
                        const float vg = (acc[ai][0][m][n][j] - mu * c1g[j]) * rs + c2g[j];
                        const float vu = (acc[ai][1][m][n][j] - mu * c1u[j]) * rs + c2u[j];
                        hv[j] = silu_f(vg) * vu; }
                    wv[2 * n] = cvt_pk_bf16(hv[0], hv[1]); wv[2 * n + 1] = cvt_pk_bf16(hv[2], hv[3]);
                }
                *(u32x4*)rowp = (u32x4){wv[0], wv[1], wv[2], wv[3]};
                if (m == 3) asm volatile("" ::: "memory");
            }
    }
};
struct EpiResid {
    static constexpr bool PERM = true;
    bf16_t* Z; const float* st_in; const float* lng; const float* lnb; float* st_out; float bscale;
    __device__ __forceinline__ const float* stat_ptr() const { return st_in; }
    __device__ __forceinline__ const float* v1_ptr() const { return lng; }
    __device__ __forceinline__ const float* v2_ptr() const { return lnb; }
    __device__ __forceinline__ void operator()(const f32x4 (&acc)[2][2][4][2], const Unit& u, int wr, int wc, int fr, int fq, const LAS f32x2* S, const LAS float* C) const {
        const int col0 = u.pn * 256 + wc * 32 + 8 * fq;
#pragma unroll
        for (int ai = 0; ai < 2; ++ai) {
            u32x4 zin[4][2];
#pragma unroll
            for (int m = 0; m < 4; ++m)
#pragma unroll
                for (int bj = 0; bj < 2; ++bj) zin[m][bj] = *(const u32x4*)(Z + (size_t)(u.pm * 256 + ai * 128 + wr * 64 + m * 16 + fr) * DM + col0 + bj * 128);
#pragma unroll
            for (int m = 0; m < 4; ++m) {
                const int row = u.pm * 256 + ai * 128 + wr * 64 + m * 16 + fr; const f32x2 sr_ = S[ai * 128 + wr * 64 + m * 16 + fr]; const float mu = sr_.x, rs = sr_.y;
                float s = 0.f, ss = 0.f;
#pragma unroll
                for (int bj = 0; bj < 2; ++bj) {
                    bf16_t* p = Z + (size_t)row * DM + col0 + bj * 128;
                    const u32x4 zo = zin[m][bj]; float zf[8];
                    zf[0] = bf_lo(zo.x); zf[1] = bf_hi(zo.x); zf[2] = bf_lo(zo.y); zf[3] = bf_hi(zo.y); zf[4] = bf_lo(zo.z); zf[5] = bf_hi(zo.z); zf[6] = bf_lo(zo.w); zf[7] = bf_hi(zo.w);
                    float zn[8];
#pragma unroll
                    for (int n = 0; n < 2; ++n) {
                        f32x4 gv = {1.f, 1.f, 1.f, 1.f}, bv = {0.f, 0.f, 0.f, 0.f};
                        if (st_in) { gv = *(const LAS f32x4*)(C + wc * 32 + 8 * fq + bj * 128 + 4 * n); bv = *(const LAS f32x4*)(C + 256 + wc * 32 + 8 * fq + bj * 128 + 4 * n); }
#pragma unroll
                        for (int j = 0; j < 4; ++j) { const float xn = (zf[4 * n + j] - mu) * rs * gv[j] + bv[j]; zn[4 * n + j] = ALPHA * xn + bscale * acc[ai][bj][m][n][j]; } }
                    u32x4 w; w.x = cvt_pk_bf16(zn[0], zn[1]); w.y = cvt_pk_bf16(zn[2], zn[3]); w.z = cvt_pk_bf16(zn[4], zn[5]); w.w = cvt_pk_bf16(zn[6], zn[7]);
                    *(u32x4*)p = w;
                    const float r0 = bf_lo(w.x), r1 = bf_hi(w.x), r2 = bf_lo(w.y), r3 = bf_hi(w.y), r4 = bf_lo(w.z), r5 = bf_hi(w.z), r6 = bf_lo(w.w), r7 = bf_hi(w.w);
                    s += ((r0 + r1) + (r2 + r3)) + ((r4 + r5) + (r6 + r7));
                    ss += ((r0 * r0 + r1 * r1) + (r2 * r2 + r3 * r3)) + ((r4 * r4 + r5 * r5) + (r6 * r6 + r7 * r7));
                }
                s += __shfl_xor(s, 16); s += __shfl_xor(s, 32); ss += __shfl_xor(ss, 16); ss += __shfl_xor(ss, 32);
                if (fq == 0) *(f32x2*)(st_out + (size_t)row * 32 + (u.pn * 4 + wc) * 2) = (f32x2){s, ss};
                asm volatile("" ::: "memory");
            }
        }
    }
};
struct EpiProj {
    static constexpr bool PERM = true;
    bf16_t* P0; bf16_t* P1; const float* st; const float* c1; const float* c2; const float* rope; const float* lbf; const float* lbb;
    __device__ __forceinline__ const float* stat_ptr() const { return st; }
    __device__ __forceinline__ const float* v1_ptr() const { return nullptr; }
    __device__ __forceinline__ const float* v2_ptr() const { return nullptr; }
    __device__ __forceinline__ void operator()(const f32x4 (&acc)[2][2][4][2], const Unit& u, int wr, int wc, int fr, int fq, const LAS f32x2* S, const LAS float* C) const {
        const int grp = u.pn >> 1, colt = u.pn * 256 + wc * 32 + 8 * fq, cgrp = (u.pn & 1) * 256 + wc * 32 + 8 * fq;
        const bool isf = (grp == 4 || grp == 5); const float* lbp = (grp == 4) ? lbf : lbb;
        const bool ropew = (grp == 0 || grp == 2) && !(wc & 1);
#pragma unroll
        for (int bj = 0; bj < 2; ++bj) {
            const f32x4 c1a = *(const f32x4*)(c1 + colt + bj * 128), c1b = *(const f32x4*)(c1 + colt + bj * 128 + 4), c2a = *(const f32x4*)(c2 + colt + bj * 128), c2b = *(const f32x4*)(c2 + colt + bj * 128 + 4);
            f32x4 lb0 = {0.f, 0.f, 0.f, 0.f}, lb1 = {0.f, 0.f, 0.f, 0.f};
            if (isf) { lb0 = *(const f32x4*)(lbp + cgrp + bj * 128); lb1 = *(const f32x4*)(lbp + cgrp + bj * 128 + 4); }
            f32x4 ncs0 = {0.f, 0.f, 0.f, 0.f}, ncs1 = ncs0, nsn0 = ncs0, nsn1 = ncs0;
            if (ropew) { const int row0_ = u.pm * 256 + wr * 64 + fr; const int pos0_ = row0_ < MP ? (row0_ & 4095) : (row0_ & 8191); const float* rp_ = rope + (size_t)pos0_ * 16;
                ncs0 = *(const f32x4*)rp_; ncs1 = *(const f32x4*)(rp_ + 4); nsn0 = *(const f32x4*)(rp_ + 8); nsn1 = *(const f32x4*)(rp_ + 12); }
#pragma unroll
            for (int ai = 0; ai < 2; ++ai)
#pragma unroll
                for (int m = 0; m < 4; ++m) {
                    const int row = u.pm * 256 + ai * 128 + wr * 64 + m * 16 + fr; const f32x2 sr_ = S[ai * 128 + wr * 64 + m * 16 + fr]; const float mu = sr_.x, rs = sr_.y;
                    const f32x4 cs0 = ncs0, cs1 = ncs1, sn0 = nsn0, sn1 = nsn1;
                    if (ropew && (ai * 4 + m) < 7) { const int im_ = ai * 4 + m + 1; const int rown_ = u.pm * 256 + (im_ >> 2) * 128 + wr * 64 + (im_ & 3) * 16 + fr; const int posn_ = rown_ < MP ? (rown_ & 4095) : (rown_ & 8191);
                        const float* rp_ = rope + (size_t)posn_ * 16; ncs0 = *(const f32x4*)rp_; ncs1 = *(const f32x4*)(rp_ + 4); nsn0 = *(const f32x4*)(rp_ + 8); nsn1 = *(const f32x4*)(rp_ + 12); }
                    bf16_t* rowp = (row < MP ? P0 + (size_t)row * NIN : P1 + (size_t)(row - MP) * NIN) + colt + bj * 128;
                    f32x4 v0 = (acc[ai][bj][m][0] - mu * c1a) * rs + c2a;
                    f32x4 v1 = (acc[ai][bj][m][1] - mu * c1b) * rs + c2b;
                    if (ropew) {
                        f32x4 p0, p1;
#pragma unroll
                        for (int j = 0; j < 4; ++j) { p0[j] = __shfl_xor(v0[j], 16); p1[j] = __shfl_xor(v1[j], 16); }
                        if (fq == 0) { v0 = v0 * cs0 - p0 * sn0; v1 = v1 * cs1 - p1 * sn1; }
                        else if (fq == 1) { v0 = v0 * cs0 + p0 * sn0; v1 = v1 * cs1 + p1 * sn1; }
                    }
                    if (grp == 0) { v0 = v0 * QSCALE; v1 = v1 * QSCALE; }
                    else if (grp == 1 || grp == 7) {
#pragma unroll
                        for (int j = 0; j < 4; ++j) { v0[j] = silu_f(v0[j]); v1[j] = silu_f(v1[j]); } }
                    else if (isf) {
#pragma unroll
                        for (int j = 0; j < 4; ++j) {
                            const float s0 = __builtin_amdgcn_rcpf(1.f + ex2(-v0[j] * LOG2E)), s1 = __builtin_amdgcn_rcpf(1.f + ex2(-v1[j] * LOG2E));
                            v0[j] = __builtin_amdgcn_logf(lb0[j] + (1.f - lb0[j]) * s0); v1[j] = __builtin_amdgcn_logf(lb1[j] + (1.f - lb1[j]) * s1); } }
                    u32x4 w;
                    if (grp == 1 || grp == 7 || isf) { w.x = cvt_pk_f16(v0[0], v0[1]); w.y = cvt_pk_f16(v0[2], v0[3]); w.z = cvt_pk_f16(v1[0], v1[1]); w.w = cvt_pk_f16(v1[2], v1[3]); }
                    else { w.x = cvt_pk_bf16(v0[0], v0[1]); w.y = cvt_pk_bf16(v0[2], v0[3]); w.z = cvt_pk_bf16(v1[0], v1[1]); w.w = cvt_pk_bf16(v1[2], v1[3]); }
                    *(u32x4*)rowp = w;
                    asm volatile("" ::: "memory");
                }
        }
    }
};

template <class Epi>
__device__ __forceinline__ void gemm_phase(LAS unsigned char* lds, const Gemm g, const StaticOrder& S, const Epi& E) {
    int tid = threadIdx.x; asm volatile("" : "+v"(tid));
    const int wid = __builtin_amdgcn_readfirstlane(tid >> 6), lane = tid & 63, wr = wid >> 2, wc = wid & 3, fr = lane & 15, fq = lane >> 4;
    const int K = g.K, nt = K / BK, lda = g.lda;
    unsigned voffA[2], voffB[2];
#pragma unroll
    for (int i = 0; i < 2; ++i) { int R, C; stage_rc(tid * 16 + i * 8192, R, C); const int Rb = Epi::PERM ? ((R & ~31) + perm32(R & 31)) : R;
        voffA[i] = (unsigned)(R * lda + C) * 2u; voffB[i] = (unsigned)(Rb * K + C) * 2u; }
    const size_t kstep = (size_t)(BK * 2);
    const size_t hstepA = (size_t)HALF * lda * 2, hstepB = (size_t)HALF * K * 2, tstepA = 2 * hstepA, tstepB = 2 * hstepB;
    const unsigned ldsw = (unsigned)wid * 1024u;
    const int aoff = lds_byte(wr * 64 + fr, fq * 8), boff = lds_byte(wc * 32 + fr, fq * 8);
#define PG8_ABASE(pm) ((pm) < 128 ? (const char*)g.A0 + (size_t)(pm) * tstepA : (const char*)g.A1 + (size_t)((pm) - 128) * tstepA)
#define PG8_SA(b, h) (((b) * 2 + (h)) * HTB)
#define PG8_SB(b, h) ((4 + (b) * 2 + (h)) * HTB)
#define PG8_STAGE(bufoff, gbase, voff) do { _Pragma("unroll") for (int _i = 0; _i < 2; ++_i) \
        __builtin_amdgcn_global_load_lds((const unsigned*)((const char*)(gbase) + (voff)[_i]), (LAS unsigned*)(lds + (bufoff) + ldsw + _i * 8192), 16, 0, 0); } while (0)
#define PG8_LDA(dst, b, h) do { _Pragma("unroll") for (int m = 0; m < 4; ++m) _Pragma("unroll") for (int k = 0; k < 2; ++k) dst[m][k] = *(const LAS bf16x8*)(lds + PG8_SA(b, h) + aoff + m * 2048 + k * 1024); } while (0)
#define PG8_LDB(dst, b, h) do { _Pragma("unroll") for (int n = 0; n < 2; ++n) _Pragma("unroll") for (int k = 0; k < 2; ++k) dst[n][k] = *(const LAS bf16x8*)(lds + PG8_SB(b, h) + boff + n * 2048 + k * 1024); } while (0)
#define PG8_MMA(ai, bj, At, Bt) do { __builtin_amdgcn_s_setprio(1); _Pragma("unroll") for (int m = 0; m < 4; ++m) _Pragma("unroll") for (int n = 0; n < 2; ++n) _Pragma("unroll") for (int k = 0; k < 2; ++k) \
        acc[ai][bj][m][n] = __builtin_amdgcn_mfma_f32_16x16x32_bf16(Bt[n][k], At[m][k], acc[ai][bj][m][n], 0, 0, 0); __builtin_amdgcn_s_setprio(0); } while (0)
#define PG8_WAIT_V(n) asm volatile("s_waitcnt vmcnt(" #n ")" ::: "memory")
#define PG8_WAIT_L(n) asm volatile("s_waitcnt lgkmcnt(" #n ")" ::: "memory")
#define PG8_BAR __builtin_amdgcn_s_barrier()
#define PG8_SCHED __builtin_amdgcn_sched_barrier(0)
    Unit cur, nxt; int ui = 0;
    if (!S.next(0, cur)) return;
    f32x4 acc[2][2][4][2];
#pragma unroll
    for (int a = 0; a < 2; ++a)
#pragma unroll
        for (int b = 0; b < 2; ++b)
#pragma unroll
            for (int m = 0; m < 4; ++m)
#pragma unroll
                for (int n = 0; n < 2; ++n) acc[a][b][m][n] = (f32x4){0.f, 0.f, 0.f, 0.f};
    bf16x8 At[4][2], B0[2][2], B1[2][2];
    const char* cA = PG8_ABASE(cur.pm); const char* cB = (const char*)g.Bt + (size_t)cur.pn * tstepB;
    PG8_STAGE(PG8_SB(0, 0), cB, voffB); PG8_STAGE(PG8_SB(0, 1), cB + hstepB, voffB); PG8_STAGE(PG8_SA(0, 0), cA, voffA); PG8_STAGE(PG8_SA(0, 1), cA + hstepA, voffA);
    if (wr == 1) PG8_BAR;
    PG8_WAIT_V(2); PG8_BAR;
    PG8_STAGE(PG8_SB(1, 0), cB + kstep, voffB); PG8_STAGE(PG8_SA(1, 0), cA + kstep, voffA); PG8_STAGE(PG8_SB(1, 1), cB + hstepB + kstep, voffB);
    PG8_WAIT_V(6); PG8_BAR;
    for (;;) {
        const bool has_next = S.next(ui + 1, nxt);
        { LAS f32x2* Sw = (LAS f32x2*)(lds + 131072 + 1024 + (ui & 1) * 2048); const float* stp = E.stat_ptr(); float mu_ = 0.f, rs_ = 1.f;
          if (stp) { const float* p_ = stp + (size_t)(cur.pm * 256 + (tid >> 1)) * 32 + (tid & 1) * 16;
              const f32x4 a_ = *(const f32x4*)p_, b_ = *(const f32x4*)(p_ + 4), c_ = *(const f32x4*)(p_ + 8), d_ = *(const f32x4*)(p_ + 12);
              float s_ = ((a_.x + a_.z) + (b_.x + b_.z)) + ((c_.x + c_.z) + (d_.x + d_.z)), q_ = ((a_.y + a_.w) + (b_.y + b_.w)) + ((c_.y + c_.w) + (d_.y + d_.w));
              s_ += __shfl_xor(s_, 1); q_ += __shfl_xor(q_, 1);
              mu_ = s_ * (1.f / DM); rs_ = rsqrtf(fmaxf(q_ * (1.f / DM) - mu_ * mu_, 0.f) + EPS); }
          if ((tid & 1) == 0) Sw[tid >> 1] = (f32x2){mu_, rs_};
          if (tid < 128) { const float* vp_ = (tid < 64) ? E.v1_ptr() : E.v2_ptr(); LAS float* Cw = (LAS float*)(lds + 131072 + 1024 + 4096 + (ui & 1) * 2048);
              const f32x4 v_ = vp_ ? *(const f32x4*)(vp_ + cur.pn * 256 + 4 * (tid & 63)) : (f32x4){0.f, 0.f, 0.f, 0.f};
              *(LAS f32x4*)(Cw + (tid >> 6) * 256 + 4 * (tid & 63)) = v_; } }
        const char* nA = has_next ? PG8_ABASE(nxt.pm) : cA; const char* nB = has_next ? (const char*)g.Bt + (size_t)nxt.pn * tstepB : cB;
        for (int t = 0; t < nt; t += 2) {
            const bool last = (t == nt - 2);
            const char* a1 = cA + (size_t)(t + 1) * kstep;
            const char* a2 = last ? nA : cA + (size_t)(t + 2) * kstep; const char* b2 = last ? nB : cB + (size_t)(t + 2) * kstep;
            const char* a3 = a2 + kstep; const char* b3 = b2 + kstep;
            PG8_LDB(B0, 0, 0); PG8_LDB(B1, 0, 1); PG8_SCHED; PG8_LDA(At, 0, 0); PG8_STAGE(PG8_SA(1, 1), a1 + hstepA, voffA);
            PG8_WAIT_V(8); PG8_WAIT_L(0); PG8_BAR; PG8_MMA(0, 0, At, B0); PG8_MMA(0, 1, At, B1); PG8_BAR; PG8_SCHED;
            PG8_LDA(At, 0, 1); PG8_STAGE(PG8_SB(0, 0), b2, voffB); PG8_STAGE(PG8_SB(0, 1), b2 + hstepB, voffB); PG8_STAGE(PG8_SA(0, 0), a2, voffA);
            PG8_WAIT_V(8); PG8_WAIT_L(0); PG8_BAR; PG8_MMA(1, 0, At, B0); PG8_MMA(1, 1, At, B1); PG8_BAR; PG8_SCHED;
            PG8_LDB(B0, 1, 0); PG8_LDB(B1, 1, 1); PG8_SCHED; PG8_LDA(At, 1, 0); PG8_STAGE(PG8_SA(0, 1), a2 + hstepA, voffA);
            PG8_WAIT_V(8); PG8_WAIT_L(0); PG8_BAR; PG8_MMA(0, 0, At, B0); PG8_MMA(0, 1, At, B1); PG8_BAR; PG8_SCHED;
            PG8_LDA(At, 1, 1); PG8_STAGE(PG8_SB(1, 0), b3, voffB); PG8_STAGE(PG8_SB(1, 1), b3 + hstepB, voffB); PG8_STAGE(PG8_SA(1, 0), a3, voffA);
            PG8_WAIT_V(8); PG8_WAIT_L(0); PG8_BAR; PG8_MMA(1, 0, At, B0); PG8_MMA(1, 1, At, B1); PG8_BAR; PG8_SCHED;
        }
        if (wr == 0) PG8_BAR;
#ifndef SKIP_EPI
        E(acc, cur, wr, wc, fr, fq, (const LAS f32x2*)(lds + 131072 + 1024 + (ui & 1) * 2048), (const LAS float*)(lds + 131072 + 1024 + 4096 + (ui & 1) * 2048));
#else
        if (acc[0][0][0][0][0] + acc[1][1][3][1][3] + acc[0][1][2][0][1] + acc[1][0][1][1][2] == 12345.f) ((float*)g.A0)[tid] = 1.f;
#endif
        if (!has_next) break;
#pragma unroll
        for (int a = 0; a < 2; ++a)
#pragma unroll
            for (int b = 0; b < 2; ++b)
#pragma unroll
                for (int m = 0; m < 4; ++m)
#pragma unroll
                    for (int n = 0; n < 2; ++n) acc[a][b][m][n] = (f32x4){0.f, 0.f, 0.f, 0.f};
        cur = nxt; cA = nA; cB = nB; ++ui;
        if (wr == 1) PG8_BAR;
    }
    PG8_WAIT_V(0);
    PG8_BAR;
#undef PG8_ABASE
#undef PG8_SA
#undef PG8_SB
#undef PG8_STAGE
#undef PG8_LDA
#undef PG8_LDB
#undef PG8_MMA
#undef PG8_WAIT_V
#undef PG8_WAIT_L
#undef PG8_BAR
#undef PG8_SCHED
}
}

#define KSWZ(row, colB) ((row) * 256 + ((colB) ^ (((row) & 7) << 4)))
#define SBAR() __builtin_amdgcn_sched_barrier(0)
__device__ __forceinline__ int crow(int r, int hi) { return (r & 3) + 8 * (r >> 2) + 4 * hi; }
__device__ __forceinline__ int v_st(int k, int c) { const int kk = (k & ~0xC) | ((k & 4) << 1) | ((k & 8) >> 1); return ((kk >> 3) * 4 + (c >> 5)) * 512 + ((kk & 7) * 32 + (c & 31)) * 2; }
__device__ __forceinline__ int v_rd_base(int lane) { return ((lane & 3) << 3) | (((lane >> 2) & 3) << 6) | (((lane >> 4) & 1) << 5) | (((lane >> 5) & 1) << 8); }
constexpr int v_rd_off(int d0, int ks, int half) { return d0 * 512 + ks * 4096 + half * 2048; }
template <int OFF> __device__ __forceinline__ s16x4 tr_read(int vb) { s16x4 r; asm volatile("ds_read_b64_tr_b16 %0, %1 offset:%2" : "=&v"(r) : "v"(vb), "i"(OFF) : "memory"); return r; }
#define PKF(L, H) (bf16x8){L[0], L[1], L[2], L[3], H[0], H[1], H[2], H[3]}
template <int D0> __device__ __forceinline__ void pv_one(f32x16& od, int vb, bf16x8 pa0, bf16x8 pa1, bf16x8 pa2, bf16x8 pa3) {
    const s16x4 l0 = tr_read<v_rd_off(D0, 0, 0)>(vb), h0 = tr_read<v_rd_off(D0, 0, 1)>(vb), l1 = tr_read<v_rd_off(D0, 1, 0)>(vb), h1 = tr_read<v_rd_off(D0, 1, 1)>(vb);
    const s16x4 l2 = tr_read<v_rd_off(D0, 2, 0)>(vb), h2 = tr_read<v_rd_off(D0, 2, 1)>(vb), l3 = tr_read<v_rd_off(D0, 3, 0)>(vb), h3 = tr_read<v_rd_off(D0, 3, 1)>(vb);
    asm volatile("s_waitcnt lgkmcnt(0)" ::: "memory"); SBAR();
    od = __builtin_amdgcn_mfma_f32_32x32x16_bf16(pa0, PKF(l0, h0), od, 0, 0, 0);
    od = __builtin_amdgcn_mfma_f32_32x32x16_bf16(pa1, PKF(l1, h1), od, 0, 0, 0);
    od = __builtin_amdgcn_mfma_f32_32x32x16_bf16(pa2, PKF(l2, h2), od, 0, 0, 0);
    od = __builtin_amdgcn_mfma_f32_32x32x16_bf16(pa3, PKF(l3, h3), od, 0, 0, 0);
}
#define PK4(P, BASE, OUT) do { unsigned a0_ = cvt_pk_bf16(P[BASE + 0], P[BASE + 1]), a1_ = cvt_pk_bf16(P[BASE + 2], P[BASE + 3]);   \
    unsigned b0_ = cvt_pk_bf16(P[BASE + 4], P[BASE + 5]), b1_ = cvt_pk_bf16(P[BASE + 6], P[BASE + 7]);                              \
    auto r0_ = __builtin_amdgcn_permlane32_swap(a0_, b0_, false, false); auto r1_ = __builtin_amdgcn_permlane32_swap(a1_, b1_, false, false); \
    u32x4 w_ = {r0_[0], r1_[0], r0_[1], r1_[1]}; OUT = *reinterpret_cast<bf16x8*>(&w_); } while (0)

namespace att {
constexpr int SHM_V = 16384, SHM_K = 16384, LDK = NIN;
constexpr float THR2 = 8.f;
#define MX3(a, b, c) __builtin_fmaxf(__builtin_fmaxf((a), (b)), (c))
__device__ __forceinline__ void partialSM(f32x16& p0, f32x16& p1, float& m_reg, float& alpha) {
    float a = MX3(p0[0], p0[1], p1[0]), b = MX3(p0[2], p0[3], p1[1]); a = MX3(a, p1[2], p1[3]);
#pragma unroll
    for (int r = 4; r < 16; r += 4) { a = MX3(a, p0[r], p0[r + 1]); b = MX3(b, p0[r + 2], p0[r + 3]); a = MX3(a, p1[r], p1[r + 1]); b = MX3(b, p1[r + 2], p1[r + 3]); }
    float pmax = fmaxf(a, b);
    { auto rr = __builtin_amdgcn_permlane32_swap(__float_as_uint(pmax), __float_as_uint(pmax), false, false); pmax = fmaxf(__uint_as_float(rr[0]), __uint_as_float(rr[1])); }
    if (__builtin_expect(__all(pmax <= THR2), 1)) { alpha = 1.f; }
    else { const float dl = fmaxf(pmax, 0.f); m_reg += dl; alpha = ex2(-dl);
#pragma unroll
        for (int r = 0; r < 16; ++r) { p0[r] -= dl; p1[r] -= dl; }
}
#pragma unroll
    for (int r = 0; r < 16; ++r) p0[r] = ex2(p0[r]);
}
__device__ __forceinline__ void finishSM(f32x16& p0, f32x16& p1, bf16x8& pa0, bf16x8& pa1, bf16x8& pa2, bf16x8& pa3) {
#pragma unroll
    for (int r = 0; r < 16; ++r) p1[r] = ex2(p1[r]);
#define PK4N(P, BASE, OUT) do { u32x4 w_ = {cvt_pk_bf16(P[BASE + 0], P[BASE + 1]), cvt_pk_bf16(P[BASE + 2], P[BASE + 3]), cvt_pk_bf16(P[BASE + 4], P[BASE + 5]), cvt_pk_bf16(P[BASE + 6], P[BASE + 7])}; OUT = *reinterpret_cast<bf16x8*>(&w_); } while (0)
    PK4N(p0, 0, pa0); PK4N(p0, 8, pa1); PK4N(p1, 0, pa2); PK4N(p1, 8, pa3);
#undef PK4N
}
template <bool ZEROC>
__device__ __forceinline__ void qkt_t(f32x16& p0, f32x16& p1, const char* Ks, const bf16x8* qr, int r32, int hi, int comp, float negm1) {
    if (!ZEROC) {
#pragma unroll
        for (int r = 0; r < 16; ++r) { p0[r] = negm1; p1[r] = negm1; } }
#pragma unroll
    for (int d0 = 0; d0 < 4; ++d0) { const int cb = ((comp * 4 + d0) * 16 + hi * 8) * 2;
        const bf16x8 b0 = *reinterpret_cast<const bf16x8*>(Ks + KSWZ(r32, cb));
        const bf16x8 b1 = *reinterpret_cast<const bf16x8*>(Ks + KSWZ(32 + r32, cb));
        if (ZEROC && d0 == 0) { p0 = __builtin_amdgcn_mfma_f32_32x32x16_bf16(b0, qr[0], f32x16{}, 0, 0, 0); p1 = __builtin_amdgcn_mfma_f32_32x32x16_bf16(b1, qr[0], f32x16{}, 0, 0, 0); }
        else { p0 = __builtin_amdgcn_mfma_f32_32x32x16_bf16(b0, qr[d0], p0, 0, 0, 0); p1 = __builtin_amdgcn_mfma_f32_32x32x16_bf16(b1, qr[d0], p1, 0, 0, 0); } }
}
#define qkt(P0, P1, KS, QR, R32, HI, COMP, NEGM) do { if (FAST) qkt_t<true>(P0, P1, KS, QR, R32, HI, COMP, 0.f); else qkt_t<false>(P0, P1, KS, QR, R32, HI, COMP, NEGM); } while (0)
__device__ __forceinline__ void pv_d0(f32x16* o, f32x16& lacc, int vb, bf16x8 pa0, bf16x8 pa1, bf16x8 pa2, bf16x8 pa3) {
    const bf16x8 ones = {0x3F80, 0x3F80, 0x3F80, 0x3F80, 0x3F80, 0x3F80, 0x3F80, 0x3F80};
    lacc = __builtin_amdgcn_mfma_f32_32x32x16_bf16(pa0, ones, lacc, 0, 0, 0); lacc = __builtin_amdgcn_mfma_f32_32x32x16_bf16(pa1, ones, lacc, 0, 0, 0);
    lacc = __builtin_amdgcn_mfma_f32_32x32x16_bf16(pa2, ones, lacc, 0, 0, 0); lacc = __builtin_amdgcn_mfma_f32_32x32x16_bf16(pa3, ones, lacc, 0, 0, 0);
    pv_one<0>(o[0], vb, pa0, pa1, pa2, pa3); pv_one<1>(o[1], vb, pa0, pa1, pa2, pa3); pv_one<2>(o[2], vb, pa0, pa1, pa2, pa3); pv_one<3>(o[3], vb, pa0, pa1, pa2, pa3);
}
__device__ __forceinline__ bool attn_unit(bf16_t* Pb, int seq, int h, int q0, float lam, float onem, const float* ag, char* lds, const bool FAST) {
    int tid = threadIdx.x; asm volatile("" : "+v"(tid));
    const int wid = tid >> 6, lane = tid & 63, r32 = lane & 31, hi = lane >> 5, comp = wid >> 2, wq = wid & 3;
    const int widu = __builtin_amdgcn_readfirstlane(wid);
    LAS char* ring = (LAS char*)lds;
    float* ws = (float*)(lds + 98304) + wid * 64; float* li_l = ws; float* al_l = ws + 32;
    const bf16_t* Kh = Pb + 1024 + h * 128; const bf16_t* Vh = Pb + 1536 + h * 128;
    float m_reg = 0.f; f32x16 o[4] = {}, lacc = {}; bf16x8 qr[4];
    int koff[2], voff[2];
#pragma unroll
    for (int i = 0; i < 2; ++i) { const int p = wid + 8 * i;
        { const int row = p * 4 + (lane >> 4), lc = ((lane & 15) * 16) ^ ((row & 7) << 4); koff[i] = row * LDK + (lc >> 1); }
        { const int st = 2 * p + (lane >> 5), kk = (st >> 2) * 8 + ((lane & 31) >> 2), c = (st & 3) * 32 + (lane & 3) * 8, k = kk; voff[i] = k * LDK + c; }     }
#define DMA_TILE(t, b) do { const bf16_t* kp_ = Kh + (size_t)(t) * 64 * LDK; const bf16_t* vp_ = Vh + (size_t)(t) * 64 * LDK; \
    _Pragma("unroll") for (int i_ = 0; i_ < 2; ++i_) { \
        __builtin_amdgcn_global_load_lds((const unsigned*)(kp_ + koff[i_]), (LAS unsigned*)(ring + (b) * 32768 + 16384 + (widu + 8 * i_) * 1024), 16, 0, 0); \
        __builtin_amdgcn_global_load_lds((const unsigned*)(vp_ + voff[i_]), (LAS unsigned*)(ring + (b) * 32768 + (widu + 8 * i_) * 1024), 16, 0, 0); } } while (0)
    DMA_TILE(0, 0); DMA_TILE(1, 1);
    const bf16_t* Qw = Pb + (size_t)(q0 + wq * 32 + r32) * LDK + h * 128 + comp * 64 + hi * 8;
#pragma unroll
    for (int d0 = 0; d0 < 4; ++d0) qr[d0] = *reinterpret_cast<const bf16x8*>(Qw + d0 * 16);
    const int vb0 = (int)(uintptr_t)lds + v_rd_base(lane);
#define RESC(a) do { if (__any((a) < 1.f)) { if (hi == 0) al_l[r32] = (a); asm volatile("s_waitcnt lgkmcnt(0)" ::: "memory"); \
    _Pragma("unroll") for (int r = 0; r < 16; ++r) { const float f_ = al_l[crow(r, hi)]; lacc[r] *= f_; _Pragma("unroll") for (int d = 0; d < 4; ++d) o[d][r] *= f_; } } } while (0)
    f32x16 pA0, pA1, pB0, pB1; float alA, alB; bf16x8 pa0, pa1, pa2, pa3; const int NT = seq / 64;
    asm volatile("s_waitcnt vmcnt(0)" ::: "memory"); __syncthreads();
    DMA_TILE(2, 2);
    qkt(pA0, pA1, lds + 16384, qr, r32, hi, comp, -m_reg); do { if (FAST) { alA = 1.f; _Pragma("unroll") for (int r_ = 0; r_ < 16; ++r_) pA0[r_] = ex2(pA0[r_]); } else partialSM(pA0, pA1, m_reg, alA); } while (0);
    int bcur = 1, bprev = 0, bnext = 2;
#define HALF(PC0, PC1, PP0, PP1, ALC, ALP, j) do { \
    SBAR(); qkt(PC0, PC1, lds + bcur * 32768 + 16384, qr, r32, hi, comp, -m_reg); \
    finishSM(PP0, PP1, pa0, pa1, pa2, pa3); SBAR(); \
    pv_d0(o, lacc, vb0 + bprev * 32768, pa0, pa1, pa2, pa3); do { if (FAST) { ALC = 1.f; _Pragma("unroll") for (int r_ = 0; r_ < 16; ++r_) PC0[r_] = ex2(PC0[r_]); } else partialSM(PC0, PC1, m_reg, ALC); } while (0); \
    asm volatile("s_waitcnt vmcnt(0)" ::: "memory"); __syncthreads();        \
    if ((j) + 2 < NT) DMA_TILE((j) + 2, bprev); \
    if (!FAST) RESC(ALC); \
    { const int t_ = bprev; bprev = bcur; bcur = bnext; bnext = t_; } } while (0)
    for (int j = 1; j + 1 < NT; j += 2) {
        HALF(pB0, pB1, pA0, pA1, alB, alA, j);
        HALF(pA0, pA1, pB0, pB1, alA, alB, j + 1);
    }
    SBAR(); qkt(pB0, pB1, lds + bcur * 32768 + 16384, qr, r32, hi, comp, -m_reg);
    finishSM(pA0, pA1, pa0, pa1, pa2, pa3); SBAR();
    pv_d0(o, lacc, vb0 + bprev * 32768, pa0, pa1, pa2, pa3); do { if (FAST) { alB = 1.f; _Pragma("unroll") for (int r_ = 0; r_ < 16; ++r_) pB0[r_] = ex2(pB0[r_]); } else partialSM(pB0, pB1, m_reg, alB); } while (0);
    if (!FAST) RESC(alB);
    finishSM(pB0, pB1, pa0, pa1, pa2, pa3); SBAR();
    pv_d0(o, lacc, vb0 + bcur * 32768, pa0, pa1, pa2, pa3);
    if (FAST) { float lm_ = 0.f, ln_ = 3.0e38f;
#pragma unroll
        for (int r = 0; r < 16; ++r) { const float v_ = lacc[r] != lacc[r] ? 3.0e38f : lacc[r]; lm_ = fmaxf(lm_, v_); ln_ = fminf(ln_, lacc[r]); }
        if (__syncthreads_or((!(lm_ < 1e30f) || !(ln_ > 1e-30f)) ? 1 : 0)) return true; }
    float rli[16];
#pragma unroll
    for (int r = 0; r < 16; ++r) rli[r] = __builtin_amdgcn_rcpf(lacc[r]);
    __syncthreads();
    float* X = (float*)lds + wq * 4096;
    if (comp == 1) {
#pragma unroll
        for (int d = 0; d < 4; ++d)
#pragma unroll
            for (int r = 0; r < 16; ++r) X[(d * 16 + r) * 64 + lane] = o[d][r] * rli[r];
    }
    __syncthreads();
    if (comp == 0) {
        float ssq[16];
#pragma unroll
        for (int r = 0; r < 16; ++r) { float a = 0.f;
#pragma unroll
            for (int d = 0; d < 4; ++d) { const float v = o[d][r] * rli[r] - lam * X[(d * 16 + r) * 64 + lane]; o[d][r] = v; a += v * v; }
            ssq[r] = a; }
#pragma unroll
        for (int r = 0; r < 16; ++r) { float a = ssq[r]; a += __shfl_xor(a, 1); a += __shfl_xor(a, 2); a += __shfl_xor(a, 4); a += __shfl_xor(a, 8); a += __shfl_xor(a, 16);
            ssq[r] = rsqrtf(a * (1.f / 128.f) + EPS) * onem; }
        float gg[4];
#pragma unroll
        for (int d = 0; d < 4; ++d) gg[d] = ag[d * 32 + r32];
        bf16_t* Ow = Pb + (size_t)(q0 + wq * 32) * LDK + h * 128;
#pragma unroll
        for (int r = 0; r < 16; ++r) { const int orow = crow(r, hi);
#pragma unroll
            for (int d = 0; d < 4; ++d) { const unsigned w = cvt_pk_bf16(o[d][r] * ssq[r] * gg[d], 0.f); Ow[(size_t)orow * LDK + d * 32 + r32] = (bf16_t)(w & 0xffffu); } }
    }
    __syncthreads();
#undef DMA_TILE
#undef HALF
#undef RESC
    return false;
}
#undef qkt
}

namespace hg {
constexpr int T_QR = 0, T_KR = 16384, T_QE = 32768, T_KE = 49152, T_V = 65536, T_ST = 81920, T_TOT = 114688, T_DL = 118784, TO_STRIDE = 132;
__device__ __forceinline__ void hgrn_unit(bf16_t* Pb, int seq, int h, int dir, char* lds) {
    int tid = threadIdx.x; asm volatile("" : "+v"(tid));
    const int wid = tid >> 6, lane = tid & 63, r32 = lane & 31, hi = lane >> 5;
    const int th = wid & 1, d0 = wid >> 1, kb = wid & 3, eb0 = 2 * (wid >> 2);
    char* QR = lds + T_QR; char* KR = lds + T_KR; char* QE = lds + T_QE; char* KE = lds + T_KE; char* VT = lds + T_V; char* ST = lds + T_ST;
    float* TOT = (float*)(lds + T_TOT); float* DL = (float*)(lds + T_DL); float* TO = (float*)lds;
    const int nch = seq / 64;
    const int qcol = 512 + h * 128, vcol = 3072 + h * 128, gcol = (dir == 0 ? 2048 : 2560) + h * 128;
    const int ot = tid >> 3, oe = (tid & 7) * 16;
    for (int i = tid; i < 2048; i += 512) ((u32x4*)ST)[i] = (u32x4){0u, 0u, 0u, 0u};
    f32x16 S0 = {}, S1 = {};
    unsigned G[8], Q[8], V[8];
#define HLOAD(GD, QD, VD, ch) do { const int c0_ = ((dir == 0) ? (ch) : (nch - 1 - (ch))) * 64; \
    _Pragma("unroll") for (int j = 0; j < 8; ++j) { const int i_ = 8 * wid + j; const int tok_ = c0_ + ((dir == 0) ? i_ : 63 - i_); \
        const bf16_t* rp_ = Pb + (size_t)tok_ * NIN + 2 * lane; GD[j] = *(const unsigned*)(rp_ + gcol); QD[j] = *(const unsigned*)(rp_ + qcol); VD[j] = *(const unsigned*)(rp_ + vcol); } } while (0)
    HLOAD(G, Q, V, 0);
    __syncthreads();
    for (int ch = 0; ch < nch; ++ch) {
        const int c0 = ((dir == 0) ? ch : (nch - 1 - ch)) * 64;
        float cs0[8], cs1[8];
#pragma unroll
        for (int j = 0; j < 8; ++j) { const float g0 = h_lo(G[j]), g1 = h_hi(G[j]); cs0[j] = (j ? cs0[j - 1] : 0.f) + g0; cs1[j] = (j ? cs1[j - 1] : 0.f) + g1; }
        *(f32x2*)(TOT + wid * 128 + 2 * lane) = (f32x2){cs0[7], cs1[7]};
        __syncthreads();
        float pre0 = 0.f, pre1 = 0.f, rf0 = 0.f, rf1 = 0.f, bl0 = 0.f, bl1 = 0.f;
#pragma unroll
        for (int w = 0; w < 8; ++w) { const f32x2 t = *(const f32x2*)(TOT + w * 128 + 2 * lane); if (w < wid) { pre0 += t.x; pre1 += t.y; } if (w < 4) { rf0 += t.x; rf1 += t.y; } bl0 += t.x; bl1 += t.y; }
        const float erf0 = ex2(rf0), erf1 = ex2(rf1), ebr0 = ex2(bl0 - rf0), ebr1 = ex2(bl1 - rf1);
#pragma unroll
        for (int j = 0; j < 8; ++j) {
            const int i = 8 * wid + j; const float b0 = pre0 + cs0[j], b1 = pre1 + cs1[j];
            const float e0 = ex2(b0 - rf0), e1 = ex2(b1 - rf1);
            const float qr0 = h_lo(Q[j]) * e0, qr1 = h_hi(Q[j]) * e1;
            const float kr0 = (1.f - ex2(h_lo(G[j]))) * __builtin_amdgcn_rcpf(e0), kr1 = (1.f - ex2(h_hi(G[j]))) * __builtin_amdgcn_rcpf(e1);
            const int ko = KSWZ(i, 4 * lane), vo = v_st(i, 2 * lane);
            *(unsigned*)(QR + ko) = cvt_pk_bf16(qr0, qr1);
            *(unsigned*)(QE + ko) = cvt_pk_bf16(qr0 * erf0, qr1 * erf1);
            *(unsigned*)(KR + ko) = cvt_pk_bf16(kr0, kr1);
            *(unsigned*)(KE + vo) = cvt_pk_bf16(kr0 * ebr0, kr1 * ebr1);
            *(unsigned*)(VT + vo) = V[j];
        }
        if (wid == 0) *(f32x2*)(DL + 2 * lane) = (f32x2){ex2(bl0), ex2(bl1)};
        __syncthreads();
        if (ch + 1 < nch) HLOAD(G, Q, V, ch + 1);
        const int otok = c0 + ((dir == 0) ? ot : 63 - ot);
        bf16_t* orow = Pb + (size_t)otok * NIN;
        f32x16 p0 = {}, p1 = {};
#pragma unroll
        for (int kd = 0; kd < 8; ++kd) { const int cb = (kd * 16 + hi * 8) * 2;
            const bf16x8 bq = *(const bf16x8*)(QR + KSWZ(th * 32 + r32, cb));
            const bf16x8 a0 = *(const bf16x8*)(KR + KSWZ(r32, cb));
            p0 = __builtin_amdgcn_mfma_f32_32x32x16_bf16(a0, bq, p0, 0, 0, 0);
            if (th) { const bf16x8 a1 = *(const bf16x8*)(KR + KSWZ(32 + r32, cb)); p1 = __builtin_amdgcn_mfma_f32_32x32x16_bf16(a1, bq, p1, 0, 0, 0); } }
#pragma unroll
        for (int r = 0; r < 16; ++r) { const bool keep = crow(r, hi) <= r32; if (th == 0) { p0[r] = keep ? p0[r] : 0.f; p1[r] = 0.f; } else { p1[r] = keep ? p1[r] : 0.f; } }
        bf16x8 pa0, pa1, pa2, pa3; PK4(p0, 0, pa0); PK4(p0, 8, pa1); PK4(p1, 0, pa2); PK4(p1, 8, pa3);
        f32x16 o = {};
        pv_one<0>(o, (int)(uintptr_t)VT + v_rd_base(lane) + d0 * 512, pa0, pa1, pa2, pa3);
#pragma unroll
        for (int kd = 0; kd < 8; ++kd) { const int cb = (kd * 16 + hi * 8) * 2;
            const bf16x8 a = *(const bf16x8*)(QE + KSWZ(th * 32 + r32, cb));
            const bf16x8 b = *(const bf16x8*)(ST + KSWZ(d0 * 32 + r32, cb));
            o = __builtin_amdgcn_mfma_f32_32x32x16_bf16(a, b, o, 0, 0, 0); }
#pragma unroll
        for (int r = 0; r < 16; ++r) { const float f = DL[kb * 32 + crow(r, hi)]; S0[r] *= f; S1[r] *= f; }
        { const int keb = (int)(uintptr_t)KE + v_rd_base(lane) + kb * 512, vbb = (int)(uintptr_t)VT + v_rd_base(lane) + eb0 * 512;
#define HSTEP(ks) do { const s16x4 kl = tr_read<v_rd_off(0, ks, 0)>(keb), kh = tr_read<v_rd_off(0, ks, 1)>(keb); \
            const s16x4 al = tr_read<v_rd_off(0, ks, 0)>(vbb), ah = tr_read<v_rd_off(0, ks, 1)>(vbb), bl_ = tr_read<v_rd_off(1, ks, 0)>(vbb), bh_ = tr_read<v_rd_off(1, ks, 1)>(vbb); \
            asm volatile("s_waitcnt lgkmcnt(0)" ::: "memory"); SBAR(); \
            S0 = __builtin_amdgcn_mfma_f32_32x32x16_bf16(PKF(kl, kh), PKF(al, ah), S0, 0, 0, 0); \
            S1 = __builtin_amdgcn_mfma_f32_32x32x16_bf16(PKF(kl, kh), PKF(bl_, bh_), S1, 0, 0, 0); } while (0)
          HSTEP(0); HSTEP(1); HSTEP(2); HSTEP(3);
#undef HSTEP
        }
        __syncthreads();
#pragma unroll
        for (int q4 = 0; q4 < 4; ++q4) { const int kc = (kb * 32 + 8 * q4 + 4 * hi) * 2;
            u32x2 w0, w1; w0.x = cvt_pk_bf16(S0[4 * q4], S0[4 * q4 + 1]); w0.y = cvt_pk_bf16(S0[4 * q4 + 2], S0[4 * q4 + 3]); w1.x = cvt_pk_bf16(S1[4 * q4], S1[4 * q4 + 1]); w1.y = cvt_pk_bf16(S1[4 * q4 + 2], S1[4 * q4 + 3]);
            *(u32x2*)(ST + KSWZ(eb0 * 32 + r32, kc)) = w0; *(u32x2*)(ST + KSWZ((eb0 + 1) * 32 + r32, kc)) = w1; }
#pragma unroll
        for (int r = 0; r < 16; ++r) TO[(th * 32 + crow(r, hi)) * TO_STRIDE + d0 * 32 + r32] = o[r];
        __syncthreads();
        { float ov[16];
#pragma unroll
          for (int i = 0; i < 4; ++i) { const f32x4 t = *(const f32x4*)(TO + ot * TO_STRIDE + oe + 4 * i); ov[4 * i] = t.x; ov[4 * i + 1] = t.y; ov[4 * i + 2] = t.z; ov[4 * i + 3] = t.w; }
          u32x4 w0, w1; w0.x = cvt_pk_f16(ov[0], ov[1]); w0.y = cvt_pk_f16(ov[2], ov[3]); w0.z = cvt_pk_f16(ov[4], ov[5]); w0.w = cvt_pk_f16(ov[6], ov[7]);
          w1.x = cvt_pk_f16(ov[8], ov[9]); w1.y = cvt_pk_f16(ov[10], ov[11]); w1.z = cvt_pk_f16(ov[12], ov[13]); w1.w = cvt_pk_f16(ov[14], ov[15]);
          *(u32x4*)(orow + gcol + oe) = w0; *(u32x4*)(orow + gcol + oe + 8) = w1; }
    }
    __threadfence(); __syncthreads();
#undef HLOAD
}
__device__ __forceinline__ void hgrn_combine(bf16_t* Pb, int seq, int h, const float* hgg) {
    int tid = threadIdx.x; asm volatile("" : "+v"(tid));
    const int ot = tid >> 3, oe = (tid & 7) * 16;
    float gh[16];
#pragma unroll
    for (int i = 0; i < 16; ++i) gh[i] = hgg[oe + i];
    for (int r0 = 0; r0 < seq; r0 += 64) {
        bf16_t* orow = Pb + (size_t)(r0 + ot) * NIN + h * 128 + oe;
        const u32x4 f0 = __builtin_nontemporal_load((const u32x4*)(orow + 2048)), f1 = __builtin_nontemporal_load((const u32x4*)(orow + 2048 + 8));
        const u32x4 b0 = __builtin_nontemporal_load((const u32x4*)(orow + 2560)), b1 = __builtin_nontemporal_load((const u32x4*)(orow + 2560 + 8));
        const u32x4 g0 = *(const u32x4*)(orow + 3584), g1 = *(const u32x4*)(orow + 3584 + 8);
        const unsigned fw[8] = {f0.x, f0.y, f0.z, f0.w, f1.x, f1.y, f1.z, f1.w}, bw[8] = {b0.x, b0.y, b0.z, b0.w, b1.x, b1.y, b1.z, b1.w}, gw[8] = {g0.x, g0.y, g0.z, g0.w, g1.x, g1.y, g1.z, g1.w};
        float ov[16], ss = 0.f;
#pragma unroll
        for (int i = 0; i < 8; ++i) { ov[2 * i] = h_lo(fw[i]) + h_lo(bw[i]); ov[2 * i + 1] = h_hi(fw[i]) + h_hi(bw[i]); ss += ov[2 * i] * ov[2 * i] + ov[2 * i + 1] * ov[2 * i + 1]; }
        ss += __shfl_xor(ss, 1); ss += __shfl_xor(ss, 2); ss += __shfl_xor(ss, 4);
        const float rr = rsqrtf(ss * (1.f / 128.f) + EPS);
        unsigned wv[8];
#pragma unroll
        for (int i = 0; i < 8; ++i) wv[i] = cvt_pk_bf16(ov[2 * i] * rr * gh[2 * i] * h_lo(gw[i]), ov[2 * i + 1] * rr * gh[2 * i + 1] * h_hi(gw[i]));
        *(u32x4*)(orow + 512) = (u32x4){wv[0], wv[1], wv[2], wv[3]}; *(u32x4*)(orow + 512 + 8) = (u32x4){wv[4], wv[5], wv[6], wv[7]};
    }
}
}

__device__ __forceinline__ void prep_weight_item(const float* W, int K, int N, int n0, bf16_t* WT, int drow0, const float* g, const float* b, float* c1, float* c2, LAS float* scr, int lane, int kbeg, int kend) {
    float c1a[4] = {0.f, 0.f, 0.f, 0.f}, c2a[4] = {0.f, 0.f, 0.f, 0.f};
    const int c = lane & 7;
    for (int k0 = kbeg; k0 < kend; k0 += 64) {
#pragma unroll 8
        for (int i = 0; i < 32; ++i) { const int kk = 2 * i + (lane >> 5); scr[kk * 33 + (lane & 31)] = W[(size_t)(k0 + kk) * N + n0 + (lane & 31)]; }
        asm volatile("s_waitcnt lgkmcnt(0)" ::: "memory");
        float gk[8], bk[8];
#pragma unroll
        for (int i = 0; i < 8; ++i) { gk[i] = g ? g[k0 + 8 * c + i] : 1.f; bk[i] = b ? b[k0 + 8 * c + i] : 0.f; }
#pragma unroll
        for (int j = 0; j < 4; ++j) { const int n = (lane >> 3) + 8 * j; const LAS float* s = scr + (8 * c) * 33 + n;
            float w[8];
#pragma unroll
            for (int i = 0; i < 8; ++i) w[i] = s[i * 33];
            u32x4 o; o.x = cvt_pk_bf16(w[0] * gk[0], w[1] * gk[1]); o.y = cvt_pk_bf16(w[2] * gk[2], w[3] * gk[3]); o.z = cvt_pk_bf16(w[4] * gk[4], w[5] * gk[5]); o.w = cvt_pk_bf16(w[6] * gk[6], w[7] * gk[7]);
            c1a[j] += ((bf_lo(o.x) + bf_hi(o.x)) + (bf_lo(o.y) + bf_hi(o.y))) + ((bf_lo(o.z) + bf_hi(o.z)) + (bf_lo(o.w) + bf_hi(o.w)));
#pragma unroll
            for (int i = 0; i < 8; ++i) c2a[j] += bk[i] * w[i];
            *(u32x4*)(WT + (size_t)(drow0 + n) * K + k0 + 8 * c) = o; }
        asm volatile("s_waitcnt lgkmcnt(0)" ::: "memory");
    }
    if (c1) {
#pragma unroll
        for (int j = 0; j < 4; ++j) { float a = c1a[j], d = c2a[j]; a += __shfl_xor(a, 1); a += __shfl_xor(a, 2); a += __shfl_xor(a, 4); d += __shfl_xor(d, 1); d += __shfl_xor(d, 2); d += __shfl_xor(d, 4);
            if (c == 0) { const int n = (lane >> 3) + 8 * j; c1[drow0 + n] = a; c2[drow0 + n] = d; } }
    }
}

#define XB_TMO      128
#define XB_XCNT(j)  (256  + 64 * (j))
#define XB_XSUB(j)  (1280 + 64 * (j))
#define XB_XGEN(j)  (2304 + 64 * (j))
#define XB_TOP      3328
#define XB_TOPGEN   3392
#define XCD_BAR_WORDS 3456
#define XB_SPIN_CAP (1u << 18)

__device__ __forceinline__ unsigned xb_ld(unsigned* p)              { return __hip_atomic_load(p, __ATOMIC_RELAXED, __HIP_MEMORY_SCOPE_AGENT); }
__device__ __forceinline__ unsigned xb_add(unsigned* p, unsigned v) { return __hip_atomic_fetch_add(p, v, __ATOMIC_RELAXED, __HIP_MEMORY_SCOPE_AGENT); }
__device__ __forceinline__ unsigned xb_xcc_id() { return (unsigned)__builtin_amdgcn_s_getreg((3 << 11) | 20) & 0xFu; }
#define XB_SPIN(cond, bar) do { unsigned _sp = 0; while (cond) { __builtin_amdgcn_s_sleep(1); \
    if ((++_sp & 255u) == 0u) { if (xb_ld(&(bar)[XB_TMO])) break; if (_sp > XB_SPIN_CAP) { atomicAdd(&(bar)[XB_TMO], 1u); break; } } } } while (0)

struct XcdBarrier {
    unsigned* bar; unsigned x;
    volatile LAS unsigned* st;
};

__device__ __forceinline__ XcdBarrier xcd_barrier_post(unsigned* bar, volatile LAS unsigned* st) {
    XcdBarrier b; b.bar = bar; b.x = xb_xcc_id(); b.st = st;
    if (threadIdx.x == 0) (void)xb_add(&bar[XB_XCNT(b.x)], 1u);
    return b;
}
__device__ __forceinline__ void xcd_barrier_complete(unsigned* bar, unsigned x, unsigned& nloc, unsigned& nx) {
    const unsigned G = gridDim.x * gridDim.y * gridDim.z;
    unsigned sum, cnt, mine, sp = 0u;
    for (;;) {
        sum = 0u; cnt = 0u; mine = 0u;
#pragma unroll
        for (unsigned j = 0; j < 16; ++j) { const unsigned c = xb_ld(&bar[XB_XCNT(j)]); sum += c; cnt += (c > 0u) ? 1u : 0u; mine = (j == x) ? c : mine; }
        if (sum == G) break;
        __builtin_amdgcn_s_sleep(1);
        if ((++sp & 255u) == 0u) { if (xb_ld(&bar[XB_TMO])) break; if (sp > XB_SPIN_CAP) { atomicAdd(&bar[XB_TMO], 1u); break; } }
    }
    nloc = mine > 0u ? mine : 1u; nx = cnt > 0u ? cnt : 1u;
}

__device__ __forceinline__ void xcd_barrier(const XcdBarrier& b) {
    asm volatile("s_waitcnt vmcnt(0)" ::: "memory");
    __syncthreads();
    if (threadIdx.x == 0) {
        unsigned* bar = b.bar;
        __builtin_amdgcn_s_waitcnt(0);
        unsigned nloc = b.st[0], nx = b.st[1];
        if (nloc == 0u) { xcd_barrier_complete(bar, b.x, nloc, nx); b.st[0] = nloc; b.st[1] = nx; }
        const unsigned old = xb_add(&bar[XB_XSUB(b.x)], 1u);
        const unsigned gen = old / nloc;
        if (old + 1u == (gen + 1u) * nloc) {
            __builtin_amdgcn_fence(__ATOMIC_RELEASE, "agent");
            asm volatile("s_waitcnt vmcnt(0)" ::: "memory");
            const unsigned og = xb_add(&bar[XB_TOP], 1u);
            const unsigned tg = og / nx;
            if (og + 1u == (tg + 1u) * nx) xb_add(&bar[XB_TOPGEN], 1u);
            else XB_SPIN(xb_ld(&bar[XB_TOPGEN]) == tg, bar);
            __builtin_amdgcn_fence(__ATOMIC_ACQUIRE, "agent");
            xb_add(&bar[XB_XGEN(b.x)], 1u);
            asm volatile("s_waitcnt vmcnt(0)" ::: "memory");
        } else {
            XB_SPIN(xb_ld(&bar[XB_XGEN(b.x)]) == gen, bar);
            __builtin_amdgcn_fence(__ATOMIC_ACQUIRE, "agent");
            asm volatile("s_waitcnt vmcnt(0)" ::: "memory");
        }
    }
    __syncthreads();
}


constexpr int NWAVES = 8, LDS_BYTES = 147456, MISC_OFF = 131072;
constexpr int N_PHASES = 16;
struct Args { const float* in[13]; float* out; unsigned char* ws; int ph_lo, ph_hi; };

__global__ void __launch_bounds__(NWAVES * 64, 2) fwd_kernel(Args a) {
    extern __shared__ __attribute__((aligned(16))) unsigned char lds[];
    LAS unsigned char* ldsl = (LAS unsigned char*)lds;
    const int G = gridDim.x, bx = blockIdx.x;
    unsigned char* ws = a.ws;
    unsigned* ctl = (unsigned*)(ws + WS_CTL); float* lamv = (float*)(ws + WS_CTL + 1024); float* LB = (float*)(ws + WS_CTL + 4096);
    float* stats = (float*)(ws + WS_STATS); float* rope = (float*)(ws + WS_ROPE); float* vec = (float*)(ws + WS_VEC);
    bf16_t* Wgu = (bf16_t*)(ws + WS_WGU); bf16_t* Wd = (bf16_t*)(ws + WS_WD); bf16_t* Win = (bf16_t*)(ws + WS_WIN); bf16_t* Wout = (bf16_t*)(ws + WS_WOUT);
    bf16_t* Z = (bf16_t*)(ws + WS_Z); bf16_t* BIG0 = (bf16_t*)a.out; bf16_t* BIG1 = (bf16_t*)(ws + WS_BIGS);
    const float* ln_g = (const float*)(ws + WS_CTL + 65536); const float* ln_b = ln_g + 6144; const float* attn_g = ln_g + 12288; const float* hg_g = ln_g + 12544;
    cg::grid_group grid = cg::this_grid();
    const int lo = a.ph_lo, hi = a.ph_hi;

    int ph = lo;
    if (ph == 0) {
        int tid = threadIdx.x; asm volatile("" : "+v"(tid));
        const int lane = tid & 63, wave = __builtin_amdgcn_readfirstlane(tid >> 6);
        {
            const float* ln_g = a.in[11]; const float* ln_b = a.in[12];
#ifndef SKIP_PRO
            const int gw = bx * NWAVES + wave, NGW = G * NWAVES, gt = bx * 512 + tid, NGT = G * 512;
            LAS float* scr = (LAS float*)(ldsl + wave * 16384);
            for (int it = gw; it < 1536; it += NGW) {
                int r = it;
                if (r < 512) { const int kq = r & 3, r4 = r >> 2, fi = r4 >> 5, nb = r4 & 31; prep_weight_item(a.in[10] + (size_t)fi * DFF * DM, DFF, DM, nb * 32, Wd + (size_t)fi * DM * DFF, nb * 32, nullptr, nullptr, nullptr, nullptr, scr, lane, kq * 704, kq * 704 + 704); continue; }
                r -= 512;
                if (r < 704) { const int fi = r / 176, r2 = r % 176, which = r2 / 88, nb = r2 % 88, n0 = nb * 32;
                    const int lni = (fi == 0) ? -1 : (fi == 1) ? 1 : (fi == 2) ? 2 : 4;
                    prep_weight_item((which ? a.in[9] : a.in[8]) + (size_t)fi * DM * DFF, DM, DFF, n0, Wgu + (size_t)fi * NGU * DM, 256 * (n0 >> 7) + 128 * which + (n0 & 127),
                                     lni < 0 ? nullptr : ln_g + lni * DM, lni < 0 ? nullptr : ln_b + lni * DM, vec + V_C1GU + fi * NGU, vec + V_C2GU + fi * NGU, scr, lane, 0, DM); continue; }
                r -= 704;
                if (r < 256) { const int l = r >> 7, nb = r & 127, n0 = nb * 32, sg = n0 >> 9; const int dg = (sg == 1) ? 2 : (sg == 2) ? 3 : (sg == 3) ? 1 : sg; const int lni = l ? 3 : 0;
                    prep_weight_item(a.in[2] + (size_t)l * DM * NIN, DM, NIN, n0, Win + (size_t)l * NIN * DM, dg * 512 + (n0 & 511), ln_g + lni * DM, ln_b + lni * DM, vec + V_C1IN + l * NIN, vec + V_C2IN + l * NIN, scr, lane, 0, DM); continue; }
                r -= 256;
                { const int l = r >> 5, nb = r & 31; prep_weight_item(a.in[3] + (size_t)l * DM * DM, DM, DM, nb * 32, Wout + (size_t)l * DM * DM, nb * 32, nullptr, nullptr, nullptr, nullptr, scr, lane, 0, DM); }
            }
            for (int m = gw; m < MTOK; m += NGW) {
                const float* xr = (m < MP) ? a.in[0] + (size_t)m * DM : a.in[1] + (size_t)(m - MP) * DM;
                u32x2* o8 = (u32x2*)(Z + (size_t)m * DM) + lane;
#pragma unroll
                for (int j = 0; j < 4; ++j) { const f32x4 v = *((const f32x4*)xr + lane + 64 * j); u32x2 w; w.x = cvt_pk_bf16(v.x, v.y); w.y = cvt_pk_bf16(v.z, v.w); o8[64 * j] = w; }
            }
            for (int i = gt; i < 8192 * 8; i += NGT) { const int pos = i >> 3, d = i & 7; const double inv = d == 0 ? 1 : d == 1 ? 0.1939227447486857733425 : d == 2 ? 0.0376060309308639356812 : d == 3 ? 0.0072926647372171090477 : d == 4 ? 0.0014142135623730950488 : d == 5 ? 0.0002742481756762073182 : d == 6 ? 0.0000531829589694498861 : 0.0000103133853772124588; const double ang = (double)pos * inv;
                double r = ang - 6.283185307179586476925 * __builtin_rint(ang * 0.15915494309189533577); const double y = r * 0.25, y2 = y * y;
                double sn = y * (1.0 + y2 * (-1.0 / 6 + y2 * (1.0 / 120 + y2 * (-1.0 / 5040 + y2 * (1.0 / 362880 + y2 * (-1.0 / 39916800 + y2 * (1.0 / 6227020800.0)))))));
                double cs = 1.0 + y2 * (-0.5 + y2 * (1.0 / 24 + y2 * (-1.0 / 720 + y2 * (1.0 / 40320 + y2 * (-1.0 / 3628800 + y2 * (1.0 / 479001600.0 + y2 * (-1.0 / 87178291200.0)))))));
                { const double s2 = 2.0 * sn * cs, c2 = 1.0 - 2.0 * sn * sn; sn = 2.0 * s2 * c2; cs = 1.0 - 2.0 * s2 * s2; }
                rope[pos * 16 + d] = (float)cs; rope[pos * 16 + 8 + d] = (float)sn; }
            if (gt < 1024) { const int dir = gt >> 9, c = gt & 511; const float x0 = a.in[7][(dir * 2 + 0) * 512 + c], x1 = a.in[7][(dir * 2 + 1) * 512 + c];
                LB[(dir * 2 + 0) * 512 + c] = 0.f; LB[(dir * 2 + 1) * 512 + c] = 1.f / (1.f + expf(x0 - x1)); }
            if (gt < 2) { const float* lp = a.in[4] + gt * 256; float s01 = 0.f, s23 = 0.f; for (int i = 0; i < 64; ++i) { s01 += lp[i] * lp[64 + i]; s23 += lp[128 + i] * lp[192 + i]; }
                const float li = 0.8f - 0.6f * expf(-0.3f * (float)gt); lamv[gt] = expf(s01) - expf(s23) + li; lamv[2 + gt] = 1.f - li; }
            if (gt < 256) ctl[gt] = 0u;
            for (int i = gt; i < XCD_BAR_WORDS; i += NGT) ((unsigned*)(ws + WS_CTL + 131072))[i] = 0u;
            { float* prm = (float*)(ws + WS_CTL + 65536);
              for (int i = gt; i < 6144; i += NGT) { prm[i] = ln_g[i]; prm[6144 + i] = ln_b[i]; }
              if (gt < 256) { prm[12288 + gt] = a.in[5][gt]; prm[12544 + gt] = a.in[6][gt]; } }
#endif
        }
        ++ph; if (ph < hi) grid.sync();
    }
    { int t_ = threadIdx.x; asm volatile("" : "+v"(t_)); if (t_ < 2) ((volatile LAS unsigned*)(ldsl + MISC_OFF + 64))[t_] = 0u; }
    __syncthreads();
    const XcdBarrier xbar = xcd_barrier_post((unsigned*)(ws + WS_CTL + 131072), (volatile LAS unsigned*)(ldsl + MISC_OFF + 64));
    bool first = true;
    for (; ph < hi; ++ph) {
        if (!first) xcd_barrier(xbar);
        first = false;
        int tid = threadIdx.x; asm volatile("" : "+v"(tid));
        const int lane = tid & 63, wave = __builtin_amdgcn_readfirstlane(tid >> 6);
        if (ph == N_PHASES - 1) {
            const int gw = bx * NWAVES + wave, NGW = G * NWAVES; const float* st = stats + 1 * STAT_STRIDE; const float* gg = ln_g + 5 * DM; const float* bb = ln_b + 5 * DM;
            for (int m = gw; m < MTOK; m += NGW) { float mu, rs; row_stat(st, m, lane >> 4, mu, rs);
                const u32x2* zr = (const u32x2*)(Z + (size_t)m * DM) + lane; f32x4* orow = (f32x4*)(a.out + (size_t)m * DM) + lane;
#pragma unroll
                for (int j = 0; j < 4; ++j) { const u32x2 w = zr[64 * j]; const f32x4 gv = *((const f32x4*)gg + lane + 64 * j), bv = *((const f32x4*)bb + lane + 64 * j);
                    f32x4 v = {bf_lo(w.x), bf_hi(w.x), bf_lo(w.y), bf_hi(w.y)}; orow[64 * j] = (v - mu) * rs * gv + bv; } }
        } else {
            const int l = (ph - 1) / 7, sub = (ph - 1) % 7;
            if (sub == 0 || sub == 5) {
                const int s = 3 * l + (sub == 0 ? 0 : 2), fi = 2 * l + (sub == 0 ? 0 : 1);
                pg8::Gemm g{Z, Z + (size_t)MP * DM, DM, Wgu + (size_t)fi * NGU * DM, MTOK, NGU, DM}; pg8::StaticOrder S; S.init(MTOK, NGU, G, bx);
                pg8::EpiSwiGLU E{BIG0, BIG1, s == 0 ? nullptr : stats + ((s - 1) & 1) * STAT_STRIDE, vec + V_C1GU + fi * NGU, vec + V_C2GU + fi * NGU};

#ifndef SKIP_G1
                pg8::gemm_phase<pg8::EpiSwiGLU>(ldsl, g, S, E);
#endif

            } else if (sub == 1 || sub == 6) {
                const int s = 3 * l + (sub == 1 ? 0 : 2), fi = 2 * l + (sub == 1 ? 0 : 1);
                pg8::Gemm g{BIG0, BIG1, DFF, Wd + (size_t)fi * DM * DFF, MTOK, DM, DFF}; pg8::StaticOrder S; S.init(MTOK, DM, G, bx);
                pg8::EpiResid E{Z, s == 0 ? nullptr : stats + ((s - 1) & 1) * STAT_STRIDE, s == 0 ? nullptr : ln_g + (s - 1) * DM, s == 0 ? nullptr : ln_b + (s - 1) * DM, stats + (s & 1) * STAT_STRIDE, 0.5f};

#ifndef SKIP_G2
                pg8::gemm_phase<pg8::EpiResid>(ldsl, g, S, E);
#endif
            } else if (sub == 2) {
                const int s = 3 * l + 1;
                pg8::Gemm g{Z, Z + (size_t)MP * DM, DM, Win + (size_t)l * NIN * DM, MTOK, NIN, DM}; pg8::StaticOrder S; S.init(MTOK, NIN, G, bx);
                pg8::EpiProj E{BIG0, BIG1, stats + ((s - 1) & 1) * STAT_STRIDE, vec + V_C1IN + l * NIN, vec + V_C2IN + l * NIN, rope, LB + (0 * 2 + l) * 512, LB + (1 * 2 + l) * 512};

#ifndef SKIP_G3
                pg8::gemm_phase<pg8::EpiProj>(ldsl, g, S, E);
#endif

            } else if (sub == 3) {
                volatile unsigned* misc = (volatile unsigned*)(lds + MISC_OFF);
                const float lam = lamv[l], onem = lamv[2 + l];
                const int myx = (int)(__builtin_amdgcn_s_getreg((3 << 11) | 20) & 7u);
                for (int qi = 0; qi < 8; ++qi) {
                    const int x = (myx + qi) & 7;
                    for (;;) {
                        __syncthreads();
                        if (tid == 0) misc[0] = atomicAdd(ctl + l * 8 + x, 1u);
                        __syncthreads();
                        const int it = (int)misc[0];
                        if (it >= 268) break;
#ifndef SKIP_HG
                        if (it < 12) {
                            const bool smp = it < 4; const int p = smp ? 2 * x + (it >> 1) : 4 * x + ((it - 4) >> 1), dir = it & 1, b = p >> 2, h = p & 3, seq = smp ? 8192 : 4096;
                            bf16_t* Pb = smp ? BIG1 + (size_t)b * 8192 * NIN : BIG0 + (size_t)b * 4096 * NIN;
                            hg::hgrn_unit(Pb, seq, h, dir, (char*)lds);
                            if (tid == 0) misc[1] = atomicAdd(ctl + 64 + l * 48 + (smp ? p : 16 + p), 1u);
                            __syncthreads();
                            if (misc[1] == 1u) { __threadfence(); hg::hgrn_combine(Pb, seq, h, hg_g + l * 128); }
                        }
#endif
#ifndef SKIP_ATT
                        if (it >= 12) {
                            const bool smp = it < 140; const int j = smp ? it - 12 : it - 140, bh = smp ? 2 * x + (j >> 6) : 4 * x + (j >> 5), qb = smp ? (j & 63) : (j & 31), seq = smp ? 8192 : 4096;
                            bf16_t* Pb = smp ? BIG1 + (size_t)(bh >> 2) * 8192 * NIN : BIG0 + (size_t)(bh >> 2) * 4096 * NIN;
                            int fastv = 1;
                            for (;;) {
                                asm volatile("" : "+s"(fastv));
                                const bool bad = att::attn_unit(Pb, seq, bh & 3, qb * 128, lam, onem, attn_g + l * 128, (char*)lds, fastv != 0);
                                if (!bad) break;
                                fastv = 0;
                            }
                        }
#endif
                    }
                }
            } else {
                const int s = 3 * l + 1;
                pg8::Gemm g{BIG0, BIG1, NIN, Wout + (size_t)l * DM * DM, MTOK, DM, DM}; pg8::StaticOrder S; S.init(MTOK, DM, G, bx);
                pg8::EpiResid E{Z, stats + ((s - 1) & 1) * STAT_STRIDE, ln_g + (s - 1) * DM, ln_b + (s - 1) * DM, stats + (s & 1) * STAT_STRIDE, 1.0f};

#ifndef SKIP_G4
                pg8::gemm_phase<pg8::EpiResid>(ldsl, g, S, E);
#endif
            }
        }
    }
}

#ifndef MK_ONE_LAUNCH
#define MK_ONE_LAUNCH 1
#endif
extern "C" void kernel_launch(void* const* d_in, const int* in_sizes, int n_in, void* d_out, int out_size, void* d_ws, size_t ws_size, hipStream_t stream) {
    static int grid = 0;
    if (grid == 0) {
        if (n_in != 13 || out_size != MTOK * DM || ws_size < WS_END) { fprintf(stderr, "kernel_launch: unexpected shapes (n_in %d out %d ws %zu)\n", n_in, out_size, ws_size); grid = -1; return; }
        if (hipFuncSetAttribute((const void*)fwd_kernel, hipFuncAttributeMaxDynamicSharedMemorySize, LDS_BYTES) != hipSuccess) { fprintf(stderr, "kernel_launch: hipFuncSetAttribute failed\n"); grid = -1; return; }
        int dev = 0, cus = 0, per_cu = 0;
        hipGetDevice(&dev); hipDeviceGetAttribute(&cus, hipDeviceAttributeMultiprocessorCount, dev);
        hipOccupancyMaxActiveBlocksPerMultiprocessor(&per_cu, (const void*)fwd_kernel, NWAVES * 64, LDS_BYTES);
        if (per_cu < 1) { fprintf(stderr, "kernel_launch: occupancy query returned %d\n", per_cu); per_cu = 1; }
        (void)hipGetLastError();
        grid = cus * 1;
    }
    if (grid < 0) return;
    Args a{};
    for (int i = 0; i < 13; ++i) a.in[i] = (const float*)d_in[i];
    a.out = (float*)d_out; a.ws = (unsigned char*)d_ws;
#if MK_ONE_LAUNCH
    a.ph_lo = 0; a.ph_hi = N_PHASES;
    void* args[] = {&a};
    hipError_t e = hipLaunchCooperativeKernel((const void*)fwd_kernel, dim3(grid), dim3(NWAVES * 64), args, LDS_BYTES, stream);
    if (e != hipSuccess) fprintf(stderr, "cooperative launch failed: %s (grid %d)\n", hipGetErrorString(e), grid);
#else
    for (int p = 0; p < N_PHASES; ++p) { a.ph_lo = p; a.ph_hi = p + 1; hipLaunchKernelGGL(fwd_kernel, dim3(grid), dim3(NWAVES * 64), LDS_BYTES, stream, a); }
#endif
}
```
